# Optimizing an MI355X kernel written in HIP

```python
import jax
import jax.numpy as jnp
from jax import lax
import numpy as np

D_MODEL = 2048
BATCH = 2
SEQ = 8192
DEPTH = 2

GRID_W = 64
CTX_LEN = 256
HEAD_DIM = 128
N_Q_HEADS = 8
N_KV_HEADS = 2
Q_PER_KV = N_Q_HEADS // N_KV_HEADS
Q_DIM = N_Q_HEADS * HEAD_DIM
KV_DIM = N_KV_HEADS * HEAD_DIM
WINDOW = 128
ATTN_BLOCK = 128
ATTN_SCALE = HEAD_DIM ** -0.5
ROPE_BASE = 10000.0
ROPE_PAIRS = HEAD_DIM // 4
CONV_DIM = D_MODEL // 2
SHORT_CONV_W = 3
EVEN_IN_DIM = Q_DIM + 2 * KV_DIM + 3 * CONV_DIM
EVEN_SPLITS = (Q_DIM, Q_DIM + KV_DIM, Q_DIM + 2 * KV_DIM, Q_DIM + 2 * KV_DIM + CONV_DIM,
               Q_DIM + 2 * KV_DIM + 2 * CONV_DIM)
D_FF = 5632
D_RNN = D_MODEL
N_RNN_HEADS = 16
RNN_HEAD_DIM = D_RNN // N_RNN_HEADS
N_DIRS = 2
RG_CONV_W = 4
RG_CONV_PAD_LEFT = 2
RG_C = 8.0
N_EXPERTS = 8
TOP_K = 2
D_FF_EXPERT = 7168
MOE_BLOCK = 128
NORM_EPS = 1e-6
NEG_INF = -1e30

kernel_name = 'hybrid_swa_shortconv_rglru_moe_prefix_dit'


def rmsnorm(h, g):
    h32 = h.astype(jnp.float32)
    y = h32 * lax.rsqrt(jnp.mean(h32 * h32, axis=-1, keepdims=True) + NORM_EPS)
    return y.astype(h.dtype) * g


def modulate(u, shift, scale):
    return u * (1 + scale) + shift


def adaln(cvec, w_mod, b_mod, n_chunks):
    width = n_chunks * D_MODEL
    m = jax.nn.silu(cvec) @ w_mod[:, :width] + b_mod[:width]
    return jnp.split(m[..., None, :], n_chunks, axis=-1)


def depthwise_conv(u, w, b, pad_left):
    width = w.shape[0]
    t = u.shape[1]
    up = jnp.pad(u, ((0, 0), (pad_left, width - 1 - pad_left), (0, 0)))
    y = b
    for tap in range(width):
        y = y + w[tap] * up[:, tap:tap + t]
    return y


def swiglu(u, w_gate, w_up, w_down):
    return (jax.nn.silu(u @ w_gate) * (u @ w_up)) @ w_down


def axial_rope_tables(n_tokens):
    rows = n_tokens // GRID_W
    row_id = jnp.broadcast_to(jnp.arange(rows)[:, None], (rows, GRID_W)).reshape(-1).astype(jnp.float32)
    col_id = jnp.broadcast_to(jnp.arange(GRID_W)[None, :], (rows, GRID_W)).reshape(-1).astype(jnp.float32)
    inv_freq = ROPE_BASE ** (-jnp.arange(ROPE_PAIRS, dtype=jnp.float32) / ROPE_PAIRS)
    ang_r = row_id[:, None] * inv_freq
    ang_c = col_id[:, None] * inv_freq
    ang = jnp.concatenate([ang_r, ang_r, ang_c, ang_c], axis=-1)
    return jnp.cos(ang), jnp.sin(ang)


def apply_rope(t, cos, sin):
    q = ROPE_PAIRS
    shape = (1, t.shape[1]) + (1,) * (t.ndim - 3) + (HEAD_DIM,)
    cos = cos.reshape(shape).astype(t.dtype)
    sin = sin.reshape(shape).astype(t.dtype)
    rot = jnp.concatenate([-t[..., q:2 * q], t[..., :q], -t[..., 3 * q:], t[..., 2 * q:3 * q]], axis=-1)
    return t * cos + rot * sin


def context_attention(q, k, v, sinks):
    bn, t = q.shape[:2]
    s = jnp.einsum('bqhgd,bkhd->bhgqk', q, k).astype(jnp.float32) * ATTN_SCALE
    sink = jnp.broadcast_to(sinks.astype(jnp.float32).reshape(1, N_KV_HEADS, Q_PER_KV, 1, 1), s.shape[:-1] + (1,))
    p = jax.nn.softmax(jnp.concatenate([sink, s], axis=-1), axis=-1)[..., 1:].astype(v.dtype)
    o = jnp.einsum('bhgqk,bkhd->bqhgd', p, v)
    return o.reshape(bn, t, Q_DIM)


def banded_blocks(t, n_blocks):
    bn = t.shape[0]
    tp = jnp.pad(t, ((0, 0), (ATTN_BLOCK, ATTN_BLOCK), (0, 0), (0, 0)))
    tp = tp.reshape(bn, n_blocks + 2, ATTN_BLOCK, N_KV_HEADS, HEAD_DIM)
    return jnp.concatenate([tp[:, :-2], tp[:, 1:-1], tp[:, 2:]], axis=2)


def windowed_attention(q, k, v, k_ctx, v_ctx, sinks):
    bn, s_len = q.shape[:2]
    n_ctx = k_ctx.shape[1]
    nb = s_len // ATTN_BLOCK
    qb = q.reshape(bn, nb, ATTN_BLOCK, N_KV_HEADS, Q_PER_KV, HEAD_DIM)
    kw = banded_blocks(k, nb)
    vw = banded_blocks(v, nb)
    s_win = jnp.einsum('bnqhgd,bnkhd->bnhgqk', qb, kw).astype(jnp.float32) * ATTN_SCALE
    s_ctx = jnp.einsum('bnqhgd,bchd->bnhgqc', qb, k_ctx).astype(jnp.float32) * ATTN_SCALE
    qi = jnp.arange(ATTN_BLOCK)
    kj = jnp.arange(3 * ATTN_BLOCK)
    rel = kj[None, :] - ATTN_BLOCK - qi[:, None]
    key_pos = jnp.arange(nb)[:, None] * ATTN_BLOCK - ATTN_BLOCK + kj[None, :]
    mask = (jnp.abs(rel) <= WINDOW)[None] & ((key_pos >= 0) & (key_pos < s_len))[:, None, :]
    s_win = jnp.where(mask[None, :, None, None], s_win, NEG_INF)
    sink = jnp.broadcast_to(sinks.astype(jnp.float32).reshape(1, 1, N_KV_HEADS, Q_PER_KV, 1, 1),
                            s_win.shape[:-1] + (1,))
    p = jax.nn.softmax(jnp.concatenate([sink, s_ctx, s_win], axis=-1), axis=-1).astype(v.dtype)
    p_ctx = p[..., 1:1 + n_ctx]
    p_win = p[..., 1 + n_ctx:]
    o = (jnp.einsum('bnhgqc,bchd->bnqhgd', p_ctx, v_ctx)
         + jnp.einsum('bnhgqk,bnkhd->bnqhgd', p_win, vw))
    return o.reshape(bn, s_len, Q_DIM)


def rglru_coeffs(xc, ga_w, ga_b, gx_w, gx_b, lam):
    bn, t, _ = xc.shape
    xh = xc.reshape(bn, t, N_RNN_HEADS, RNN_HEAD_DIM)

    def block_diag(w, b):
        y = jnp.einsum('bthi,zhij->zbthj', xh, w).reshape(N_DIRS, bn, t, D_RNN)
        return y.astype(jnp.float32) + b.astype(jnp.float32)[:, None, None, :]

    r = jax.nn.sigmoid(block_diag(ga_w, ga_b))
    i = jax.nn.sigmoid(block_diag(gx_w, gx_b))
    log_a = -RG_C * r * jax.nn.softplus(-lam.astype(jnp.float32))[:, None, None, :]
    a = jnp.exp(log_a)
    b = jnp.sqrt(-jnp.expm1(2.0 * log_a)) * i * xc.astype(jnp.float32)[None]
    return a, b


def _affine_combine(left, right):
    a_l, b_l = left
    a_r, b_r = right
    return a_l * a_r, a_r * b_l + b_r


def linear_scan(a, b, reverse):
    return lax.associative_scan(_affine_combine, (a, b), axis=1, reverse=reverse)


def moe_swiglu(xf, router_w, router_b, w_gate, w_up, w_down):
    n_tok, d = xf.shape
    logits = (xf @ router_w).astype(jnp.float32) + router_b.astype(jnp.float32)
    top_logits, top_idx = lax.top_k(logits, TOP_K)
    top_w = jax.nn.softmax(top_logits, axis=-1)
    n_assign = n_tok * TOP_K
    flat_e = top_idx.reshape(-1)
    flat_tok = jnp.arange(n_assign, dtype=jnp.int32) // TOP_K
    flat_w = top_w.reshape(-1)
    order = jnp.argsort(flat_e)
    sorted_e = flat_e[order]
    counts = jnp.zeros((N_EXPERTS,), jnp.int32).at[flat_e].add(1)
    padded = (counts + MOE_BLOCK - 1) // MOE_BLOCK * MOE_BLOCK
    pad_end = jnp.cumsum(padded)
    pad_start = pad_end - padded
    grp_start = jnp.cumsum(counts) - counts
    rank = jnp.arange(n_assign, dtype=jnp.int32) - grp_start[sorted_e]
    dest = pad_start[sorted_e] + rank
    n_blocks = -(-n_assign // MOE_BLOCK) + N_EXPERTS
    cap = n_blocks * MOE_BLOCK
    slot_tok = jnp.full((cap,), n_tok, jnp.int32).at[dest].set(flat_tok[order])
    slot_w = jnp.zeros((cap,), jnp.float32).at[dest].set(flat_w[order])
    block_e = jnp.minimum(jnp.searchsorted(pad_end, jnp.arange(n_blocks) * MOE_BLOCK, side='right'),
                          N_EXPERTS - 1)
    x_pad = jnp.concatenate([xf, jnp.zeros((1, d), xf.dtype)], axis=0)
    xb = x_pad[slot_tok].reshape(n_blocks, MOE_BLOCK, d)

    def expert_block(args):
        xblk, e = args
        return (jax.nn.silu(xblk @ w_gate[e]) * (xblk @ w_up[e])) @ w_down[e]

    yb = lax.map(expert_block, (xb, block_e)).reshape(cap, d)
    y = jax.ops.segment_sum(yb * slot_w[:, None].astype(yb.dtype), slot_tok, num_segments=n_tok + 1)
    return y[:n_tok]


def even_layer(h_c, h_l, c, c_ctx, w_mod, b_mod, norm1_g, w_in, sinks, conv_w, conv_b, w_out,
               norm2_g, ffn_w_gate, ffn_w_up, ffn_w_down, rope_cos, rope_sin):
    sh1_l, sc1_l, g1_l, sh2_l, sc2_l, g2_l = adaln(c, w_mod, b_mod, 6)
    sh1_c, sc1_c, g1_c, sh2_c, sc2_c, g2_c = adaln(c_ctx, w_mod, b_mod, 6)

    def mixer_inputs(h, shift, scale):
        z = modulate(rmsnorm(h, norm1_g), shift, scale) @ w_in
        bn, t, _ = z.shape
        q, k, v, xin, b_gate, c_gate = jnp.split(z, EVEN_SPLITS, axis=-1)
        q = q.reshape(bn, t, N_KV_HEADS, Q_PER_KV, HEAD_DIM)
        k = k.reshape(bn, t, N_KV_HEADS, HEAD_DIM)
        v = v.reshape(bn, t, N_KV_HEADS, HEAD_DIM)
        conv_out = b_gate * depthwise_conv(c_gate * xin, conv_w, conv_b, (SHORT_CONV_W - 1) // 2)
        return q, k, v, conv_out

    q_c, k_c, v_c, conv_c = mixer_inputs(h_c, sh1_c, sc1_c)
    q_l, k_l, v_l, conv_l = mixer_inputs(h_l, sh1_l, sc1_l)
    q_l = apply_rope(q_l, rope_cos, rope_sin)
    k_l = apply_rope(k_l, rope_cos, rope_sin)
    attn_c = context_attention(q_c, k_c, v_c, sinks)
    attn_l = windowed_attention(q_l, k_l, v_l, k_c, v_c, sinks)
    h_c = h_c + g1_c * (jnp.concatenate([attn_c, conv_c], axis=-1) @ w_out)
    h_l = h_l + g1_l * (jnp.concatenate([attn_l, conv_l], axis=-1) @ w_out)
    h_c = h_c + g2_c * swiglu(modulate(rmsnorm(h_c, norm2_g), sh2_c, sc2_c), ffn_w_gate, ffn_w_up, ffn_w_down)
    h_l = h_l + g2_l * swiglu(modulate(rmsnorm(h_l, norm2_g), sh2_l, sc2_l), ffn_w_gate, ffn_w_up, ffn_w_down)
    return h_c, h_l


def odd_layer(h_c, h_l, c, c_ctx, w_mod, b_mod, norm1_g, w_in, conv_w, conv_b, ga_w, ga_b, gx_w, gx_b,
              lam, w_out, norm2_g, router_w, router_b, moe_w_gate, moe_w_up, moe_w_down):
    sh1_l, sc1_l, g1_l, sh2_l, sc2_l, g2_l = adaln(c, w_mod, b_mod, 6)
    sh1_c, sc1_c = adaln(c_ctx, w_mod, b_mod, 2)
    xr_c = modulate(rmsnorm(h_c, norm1_g), sh1_c, sc1_c) @ w_in[:, D_RNN:]
    a_c, b_c = rglru_coeffs(depthwise_conv(xr_c, conv_w, conv_b, RG_CONV_PAD_LEFT), ga_w, ga_b, gx_w, gx_b, lam)
    h0_f = linear_scan(a_c[0], b_c[0], False)[1][:, -1]
    h0_b = linear_scan(a_c[1], b_c[1], True)[1][:, 0]
    z_l = modulate(rmsnorm(h_l, norm1_g), sh1_l, sc1_l) @ w_in
    gate_l, xr_l = jnp.split(z_l, [D_RNN], axis=-1)
    a_l, b_l = rglru_coeffs(depthwise_conv(xr_l, conv_w, conv_b, RG_CONV_PAD_LEFT), ga_w, ga_b, gx_w, gx_b, lam)
    cum_f, hz_f = linear_scan(a_l[0], b_l[0], False)
    cum_b, hz_b = linear_scan(a_l[1], b_l[1], True)
    rec = cum_f * h0_f[:, None] + hz_f + cum_b * h0_b[:, None] + hz_b
    y = (rec.astype(h_l.dtype) * jax.nn.gelu(gate_l)) @ w_out
    h_l = h_l + g1_l * y
    u = modulate(rmsnorm(h_l, norm2_g), sh2_l, sc2_l)
    bn, t, d = u.shape
    moe_out = moe_swiglu(u.reshape(bn * t, d), router_w, router_b, moe_w_gate, moe_w_up, moe_w_down)
    return h_l + g2_l * moe_out.reshape(bn, t, d)


def setup_inputs(seed: int = 0) -> dict:
    key = jax.random.key(seed)
    ks = iter(jax.random.split(key, 40))
    d = D_MODEL

    def nrm(shape, scale):
        return jax.random.normal(next(ks), shape, jnp.float32) * scale

    def gain():
        return 1.0 + nrm((d,), 0.02)

    u = jax.random.uniform(next(ks), (N_DIRS, D_RNN), jnp.float32, minval=0.9, maxval=0.999)
    a0 = u ** (1.0 / RG_C)
    lam = jnp.log(a0) - jnp.log1p(-a0)
    return {
        'x': nrm((BATCH, SEQ, d), 1.0),
        'c': nrm((BATCH, d), 1.0),
        'ctx': nrm((BATCH, CTX_LEN, d), 1.0),
        'c_ctx': nrm((d,), 1.0),
        'l0_w_mod': nrm((d, 6 * d), 0.5 * d ** -0.5),
        'l0_b_mod': nrm((6 * d,), 0.01),
        'l0_norm1_g': gain(),
        'l0_w_in': nrm((d, EVEN_IN_DIM), d ** -0.5),
        'l0_sinks': nrm((N_Q_HEADS,), 0.5),
        'l0_conv_w': nrm((SHORT_CONV_W, CONV_DIM), SHORT_CONV_W ** -0.5),
        'l0_conv_b': nrm((CONV_DIM,), 0.01),
        'l0_w_out': nrm((Q_DIM + CONV_DIM, d), (Q_DIM + CONV_DIM) ** -0.5),
        'l0_norm2_g': gain(),
        'l0_ffn_w_gate': nrm((d, D_FF), d ** -0.5),
        'l0_ffn_w_up': nrm((d, D_FF), d ** -0.5),
        'l0_ffn_w_down': nrm((D_FF, d), D_FF ** -0.5),
        'l1_w_mod': nrm((d, 6 * d), 0.5 * d ** -0.5),
        'l1_b_mod': nrm((6 * d,), 0.01),
        'l1_norm1_g': gain(),
        'l1_w_in': nrm((d, 2 * D_RNN), d ** -0.5),
        'l1_conv_w': nrm((RG_CONV_W, D_RNN), RG_CONV_W ** -0.5),
        'l1_conv_b': nrm((D_RNN,), 0.01),
        'l1_gate_a_w': nrm((N_DIRS, N_RNN_HEADS, RNN_HEAD_DIM, RNN_HEAD_DIM), RNN_HEAD_DIM ** -0.5),
        'l1_gate_a_b': nrm((N_DIRS, D_RNN), 0.01),
        'l1_gate_x_w': nrm((N_DIRS, N_RNN_HEADS, RNN_HEAD_DIM, RNN_HEAD_DIM), RNN_HEAD_DIM ** -0.5),
        'l1_gate_x_b': nrm((N_DIRS, D_RNN), 0.01),
        'l1_lambda': lam,
        'l1_w_out': nrm((D_RNN, d), D_RNN ** -0.5),
        'l1_norm2_g': gain(),
        'l1_router_w': nrm((d, N_EXPERTS), d ** -0.5),
        'l1_router_b': nrm((N_EXPERTS,), 0.01),
        'l1_moe_w_gate': nrm((N_EXPERTS, d, D_FF_EXPERT), d ** -0.5),
        'l1_moe_w_up': nrm((N_EXPERTS, d, D_FF_EXPERT), d ** -0.5),
        'l1_moe_w_down': nrm((N_EXPERTS, D_FF_EXPERT, d), D_FF_EXPERT ** -0.5),
        'final_norm_g': gain(),
    }


def reference(x, c, ctx, c_ctx,
              l0_w_mod, l0_b_mod, l0_norm1_g, l0_w_in, l0_sinks, l0_conv_w, l0_conv_b, l0_w_out,
              l0_norm2_g, l0_ffn_w_gate, l0_ffn_w_up, l0_ffn_w_down,
              l1_w_mod, l1_b_mod, l1_norm1_g, l1_w_in, l1_conv_w, l1_conv_b, l1_gate_a_w, l1_gate_a_b,
              l1_gate_x_w, l1_gate_x_b, l1_lambda, l1_w_out, l1_norm2_g, l1_router_w, l1_router_b,
              l1_moe_w_gate, l1_moe_w_up, l1_moe_w_down, final_norm_g):
    rope_cos, rope_sin = axial_rope_tables(x.shape[1])
    layer_params = [
        (l0_w_mod, l0_b_mod, l0_norm1_g, l0_w_in, l0_sinks, l0_conv_w, l0_conv_b, l0_w_out,
         l0_norm2_g, l0_ffn_w_gate, l0_ffn_w_up, l0_ffn_w_down),
        (l1_w_mod, l1_b_mod, l1_norm1_g, l1_w_in, l1_conv_w, l1_conv_b, l1_gate_a_w, l1_gate_a_b,
         l1_gate_x_w, l1_gate_x_b, l1_lambda, l1_w_out, l1_norm2_g, l1_router_w, l1_router_b,
         l1_moe_w_gate, l1_moe_w_up, l1_moe_w_down),
    ]
    h_c, h_l = ctx, x
    for layer in range(DEPTH):
        if layer % 2 == 0:
            h_c, h_l = even_layer(h_c, h_l, c, c_ctx, *layer_params[layer], rope_cos, rope_sin)
        else:
            h_l = odd_layer(h_c, h_l, c, c_ctx, *layer_params[layer])
    return rmsnorm(h_l, final_norm_g)
```

```cpp
#include <hip/hip_runtime.h>
#include <cstdio>
#include <cstdint>
namespace pg8 {
#define PG8_LAS __attribute__((address_space(3)))
typedef unsigned short bf16_t;
typedef short bf16x8 __attribute__((ext_vector_type(8)));
typedef float f32x4 __attribute__((ext_vector_type(4)));
typedef unsigned u32x4 __attribute__((ext_vector_type(4)));
typedef int i32x4 __attribute__((ext_vector_type(4)));
typedef int i32x8 __attribute__((ext_vector_type(8)));
constexpr int BM = 256, BK = 64, HALF = 128, HTB = HALF * BK * 2  , STAGE_BYTES = 8 * HTB, NXCD = 8, WGM = 8;

__host__ __device__ __forceinline__ int lds_byte(int r, int c) { const int st = (r >> 4) * 2 + (c >> 5), rr = r & 15, cc = c & 31, ob = rr * 64 + cc * 2; return st * 1024 + (ob ^ (((ob >> 9) & 1) << 5)); }
__host__ __device__ __forceinline__ void stage_rc(int b, int& R, int& C) { const int st = b / 1024, sb = b % 1024, swz = sb ^ (((sb >> 9) & 1) << 5); R = (st >> 1) * 16 + swz / 64; C = (st & 1) * 32 + (swz % 64) / 2; }
__host__ __device__ __forceinline__ int perm32(int rho) { const int n = rho >> 4, i = rho & 15; return 8 * (i >> 2) + 4 * n + (i & 3); }

struct Unit { int pm, pn, be, ks, pa; };
struct Gemm { const bf16_t* A; const bf16_t* Bt; int M, N, K; size_t bstride; int KL; int sw, sa; };

struct StaticOrder {
    int nM, nN, nwg, G, c;
    __host__ __device__ void init(int M, int N, int G_, int c_) { nM = M / BM; nN = N / BM; nwg = nM * nN; G = G_; c = c_; }
    __host__ __device__ bool next(int i, Unit& u) const {
        const long L = (long)i * G + c; if (L >= nwg) return false;
        int wgid = (int)L; { const int q = nwg / NXCD, r = nwg % NXCD, xcd = wgid % NXCD, off = wgid / NXCD; wgid = (xcd < r ? xcd * (q + 1) : r * (q + 1) + (xcd - r) * q) + off; }
        const int nig = WGM * nN, gid = wgid / nig, fm = gid * WGM, gsz = (nM - fm) < WGM ? (nM - fm) : WGM;
        u.pm = fm + ((wgid % nig) % gsz); u.pn = (wgid % nig) / gsz; u.be = 0; u.ks = 0; u.pa = u.pm; return true;
    }
    __device__ __forceinline__ void a_ready(const Unit&) const {}
    __device__ __forceinline__ void done(const Unit&) const {}
};

__device__ __forceinline__ unsigned cvt_pk_bf16(float lo, float hi) { unsigned r; asm volatile("v_cvt_pk_bf16_f32 %0, %1, %2" : "=v"(r) : "v"(lo), "v"(hi)); return r; }
__device__ __forceinline__ float fast_sigmoid(float x) { return __builtin_amdgcn_rcpf(1.0f + __builtin_amdgcn_exp2f(-1.4426950408889634f * x)); }
__device__ __forceinline__ float gelu_tanh(float x) { const float y = x + 0.044715f * x * x * x; return x * __builtin_amdgcn_rcpf(1.0f + __builtin_amdgcn_exp2f(-2.302208198f * y)); }

struct EpiBf16 {
    static constexpr bool PERM = true, AFTER_DRAIN = false;
    bf16_t* O; int ldc; int nact; size_t ks_stride; float ascale;
    __device__ __forceinline__ void operator()(const f32x4 (&acc)[2][2][4][2], const Unit& u, int wr, int wc, int fr, int fq) const {
        const int row0 = u.pm * BM + wr * 64 + fr, col0 = u.pn * BM + wc * 32 + 8 * fq; const bool act = u.pn < nact;
#pragma unroll
        for (int ai = 0; ai < 2; ++ai)
#pragma unroll
            for (int m = 0; m < 4; ++m) { bf16_t* rowp = O + (size_t)u.ks * ks_stride + (size_t)(row0 + ai * HALF + m * 16) * ldc + col0;
#pragma unroll
                for (int bj = 0; bj < 2; ++bj) { f32x4 v0 = acc[ai][bj][m][0] * ascale, v1 = acc[ai][bj][m][1] * ascale;
                    if (act) {
#pragma unroll
                        for (int j = 0; j < 4; ++j) { v0[j] = gelu_tanh(v0[j]); v1[j] = gelu_tanh(v1[j]); } }
                    u32x4 w; w.x = cvt_pk_bf16(v0[0], v0[1]); w.y = cvt_pk_bf16(v0[2], v0[3]); w.z = cvt_pk_bf16(v1[0], v1[1]); w.w = cvt_pk_bf16(v1[2], v1[3]);
                    *(u32x4*)(rowp + bj * HALF) = w; } }
    }
};
struct EpiSwiGLU {
    static constexpr bool PERM = true, AFTER_DRAIN = false;
    bf16_t* O; int ldc;
    __device__ __forceinline__ void operator()(const f32x4 (&acc)[2][2][4][2], const Unit& u, int wr, int wc, int fr, int fq) const {
        const int row0 = u.pm * BM + wr * 64 + fr, col0 = u.pn * HALF + wc * 32 + 8 * fq;
#pragma unroll
        for (int ai = 0; ai < 2; ++ai)
#pragma unroll
            for (int m = 0; m < 4; ++m) { bf16_t* rowp = O + (size_t)(row0 + ai * HALF + m * 16) * ldc + col0;
                f32x4 h0, h1;
#pragma unroll
                for (int j = 0; j < 4; ++j) { const float g0 = acc[ai][0][m][0][j], g1 = acc[ai][0][m][1][j];
                    h0[j] = g0 * fast_sigmoid(g0) * acc[ai][1][m][0][j]; h1[j] = g1 * fast_sigmoid(g1) * acc[ai][1][m][1][j]; }
                u32x4 w; w.x = cvt_pk_bf16(h0[0], h0[1]); w.y = cvt_pk_bf16(h0[2], h0[3]); w.z = cvt_pk_bf16(h1[0], h1[1]); w.w = cvt_pk_bf16(h1[2], h1[3]);
                *(u32x4*)rowp = w; }
    }
};
struct EpiSwiGLU8 {
    static constexpr bool PERM = true, AFTER_DRAIN = false;
    unsigned char* O; int ldc; float scale, ascale;
    typedef float f2 __attribute__((ext_vector_type(2)));
    __device__ __forceinline__ f2 swi2(f2 G, f2 U, float kexp, float kout) const {
        const f2 t = G * kexp; f2 e; e.x = __builtin_amdgcn_exp2f(t.x); e.y = __builtin_amdgcn_exp2f(t.y);
        const f2 d = e + 1.0f; f2 r; r.x = __builtin_amdgcn_rcpf(d.x); r.y = __builtin_amdgcn_rcpf(d.y);
        f2 h = (G * U) * r * kout; h.x = __builtin_amdgcn_fmed3f(h.x, -448.f, 448.f); h.y = __builtin_amdgcn_fmed3f(h.y, -448.f, 448.f); return h; }
    __device__ __forceinline__ void operator()(const f32x4 (&acc)[2][2][4][2], const Unit& u, int wr, int wc, int fr, int fq) const {
        const int row0 = u.pm * BM + wr * 64 + fr, col0 = u.pn * HALF + wc * 32 + 8 * fq;
        const float kexp = -1.4426950408889634f * ascale, kout = ascale * ascale * scale;
#pragma unroll
        for (int ai = 0; ai < 2; ++ai)
#pragma unroll
            for (int m = 0; m < 4; ++m) { unsigned char* rowp = O + (size_t)(row0 + ai * HALF + m * 16) * ldc + col0;
                const f32x4 g0 = acc[ai][0][m][0], g1 = acc[ai][0][m][1], u0 = acc[ai][1][m][0], u1 = acc[ai][1][m][1];
                const f2 a = swi2((f2){g0[0], g0[1]}, (f2){u0[0], u0[1]}, kexp, kout), b = swi2((f2){g0[2], g0[3]}, (f2){u0[2], u0[3]}, kexp, kout);
                const f2 c = swi2((f2){g1[0], g1[1]}, (f2){u1[0], u1[1]}, kexp, kout), d = swi2((f2){g1[2], g1[3]}, (f2){u1[2], u1[3]}, kexp, kout);
                int p0 = 0, p1 = 0;
                p0 = __builtin_amdgcn_cvt_pk_fp8_f32(a.x, a.y, p0, false); p0 = __builtin_amdgcn_cvt_pk_fp8_f32(b.x, b.y, p0, true);
                p1 = __builtin_amdgcn_cvt_pk_fp8_f32(c.x, c.y, p1, false); p1 = __builtin_amdgcn_cvt_pk_fp8_f32(d.x, d.y, p1, true);
                typedef unsigned u32x2 __attribute__((ext_vector_type(2))); u32x2 w; w.x = (unsigned)p0; w.y = (unsigned)p1; *(u32x2*)rowp = w; }
    }
};
struct EpiRes {
    static constexpr bool PERM = false, AFTER_DRAIN = false;
    const float* resL; const float* resC; float* outL; float* outC; const float* gate; int ldc; float ascale;
    __device__ __forceinline__ void operator()(const f32x4 (&acc)[2][2][4][2], const Unit& u, int wr, int wc, int fr, int fq) const {
        const bool isc = u.pm >= 64; const int pml = isc ? u.pm - 64 : u.pm; const int v = isc ? 2 : (u.pm >> 5);
        const float* res = isc ? resC : resL; float* out = isc ? outC : outL; const float* gv = gate + (size_t)v * 12288;
        const int row0 = pml * BM + wr * 64 + fr, col0 = u.pn * BM + wc * 32 + 4 * fq;
        f32x4 gg[2][2];
#pragma unroll
        for (int bj = 0; bj < 2; ++bj)
#pragma unroll
            for (int n = 0; n < 2; ++n) gg[bj][n] = *(const f32x4*)(gv + col0 + bj * HALF + n * 16) * ascale;
#pragma unroll
        for (int ai = 0; ai < 2; ++ai) {
            f32x4 bs[4][2][2];
#pragma unroll
            for (int m = 0; m < 4; ++m) { const size_t off = (size_t)(row0 + ai * HALF + m * 16) * ldc + col0;
#pragma unroll
                for (int bj = 0; bj < 2; ++bj)
#pragma unroll
                    for (int n = 0; n < 2; ++n) bs[m][bj][n] = *(const f32x4*)(res + off + bj * HALF + n * 16); }
#pragma unroll
            for (int m = 0; m < 4; ++m) { const size_t off = (size_t)(row0 + ai * HALF + m * 16) * ldc + col0;
#pragma unroll
                for (int bj = 0; bj < 2; ++bj)
#pragma unroll
                    for (int n = 0; n < 2; ++n) *(f32x4*)(out + off + bj * HALF + n * 16) = bs[m][bj][n] + gg[bj][n] * acc[ai][bj][m][n]; }
            asm volatile("" ::: "memory"); }
    }
};
template <bool RB> struct EpiResH {
    static constexpr bool PERM = true, AFTER_DRAIN = false;
    const float* resL; const float* resC; bf16_t* H; const float* gate; float ascale;
    __device__ __forceinline__ void operator()(const f32x4 (&acc)[2][2][4][2], const Unit& u, int wr, int wc, int fr, int fq) const {
        const bool isc = u.pm >= 64; const int v = isc ? 2 : (u.pm >> 5);
        const float* gv = gate + (size_t)v * 12288;
        const int row0 = u.pm * BM + wr * 64 + fr, col0 = u.pn * BM + wc * 32 + 8 * fq;
        f32x4 gg[2][2];
#pragma unroll
        for (int bj = 0; bj < 2; ++bj)
#pragma unroll
            for (int n = 0; n < 2; ++n) gg[bj][n] = *(const f32x4*)(gv + col0 + bj * HALF + n * 4) * ascale;
#pragma unroll
        for (int ai = 0; ai < 2; ++ai) {
            if constexpr (RB) {
                u32x4 bs[4][2];
#pragma unroll
                for (int m = 0; m < 4; ++m)
#pragma unroll
                    for (int bj = 0; bj < 2; ++bj) bs[m][bj] = *(const u32x4*)(H + (size_t)(row0 + ai * HALF + m * 16) * 2048 + col0 + bj * HALF);
#pragma unroll
                for (int m = 0; m < 4; ++m)
#pragma unroll
                    for (int bj = 0; bj < 2; ++bj) { const u32x4 b = bs[m][bj];
                        f32x4 r0, r1; r0.x = __builtin_bit_cast(float, b.x << 16); r0.y = __builtin_bit_cast(float, b.x & 0xffff0000u); r0.z = __builtin_bit_cast(float, b.y << 16); r0.w = __builtin_bit_cast(float, b.y & 0xffff0000u);
                        r1.x = __builtin_bit_cast(float, b.z << 16); r1.y = __builtin_bit_cast(float, b.z & 0xffff0000u); r1.z = __builtin_bit_cast(float, b.w << 16); r1.w = __builtin_bit_cast(float, b.w & 0xffff0000u);
                        r0 += gg[bj][0] * acc[ai][bj][m][0]; r1 += gg[bj][1] * acc[ai][bj][m][1];
                        u32x4 w; w.x = cvt_pk_bf16(r0[0], r0[1]); w.y = cvt_pk_bf16(r0[2], r0[3]); w.z = cvt_pk_bf16(r1[0], r1[1]); w.w = cvt_pk_bf16(r1[2], r1[3]);
                        *(u32x4*)(H + (size_t)(row0 + ai * HALF + m * 16) * 2048 + col0 + bj * HALF) = w; }
            } else {
                const float* res = isc ? resC - (size_t)16384 * 2048 : resL;
                f32x4 bs[4][2][2];
#pragma unroll
                for (int m = 0; m < 4; ++m)
#pragma unroll
                    for (int bj = 0; bj < 2; ++bj)
#pragma unroll
                        for (int n = 0; n < 2; ++n) bs[m][bj][n] = *(const f32x4*)(res + (size_t)(row0 + ai * HALF + m * 16) * 2048 + col0 + bj * HALF + n * 4);
#pragma unroll
                for (int m = 0; m < 4; ++m)
#pragma unroll
                    for (int bj = 0; bj < 2; ++bj) { const f32x4 r0 = bs[m][bj][0] + gg[bj][0] * acc[ai][bj][m][0], r1 = bs[m][bj][1] + gg[bj][1] * acc[ai][bj][m][1];
                        u32x4 w; w.x = cvt_pk_bf16(r0[0], r0[1]); w.y = cvt_pk_bf16(r0[2], r0[3]); w.z = cvt_pk_bf16(r1[0], r1[1]); w.w = cvt_pk_bf16(r1[2], r1[3]);
                        *(u32x4*)(H + (size_t)(row0 + ai * HALF + m * 16) * 2048 + col0 + bj * HALF) = w; }
            }
            asm volatile("" ::: "memory"); }
    }
};
struct MoeOrder {
    int nM, nN, nwg, G, c, nNr, pm0, atile; int toff[9];
    __device__ __forceinline__ void init(const int* counts, int N, int nsplit, int G_, int c_, int pm_lo = 0, int pm_hi = 1 << 20) { int t = 0;
#pragma unroll
        for (int e = 0; e < 8; ++e) { toff[e] = t; t += (__builtin_amdgcn_readfirstlane(counts[e]) + 255) >> 8; }
        toff[8] = t; atile = 0; const int hi = t < pm_hi ? t : pm_hi; pm0 = pm_lo; nM = hi > pm_lo ? hi - pm_lo : 0; nNr = N / BM; nN = nNr * nsplit; nwg = nM * nN; G = G_; c = c_; }
    __device__ __forceinline__ bool next(int i, Unit& u) const {
        const long L = (long)i * G + c; if (L >= nwg) return false;
        int wgid = (int)L; { const int q = nwg / NXCD, r = nwg % NXCD, xcd = wgid % NXCD, off = wgid / NXCD; wgid = (xcd < r ? xcd * (q + 1) : r * (q + 1) + (xcd - r) * q) + off; }
        const int nig = WGM * nN, gid = wgid / nig, fm = gid * WGM, gsz = (nM - fm) < WGM ? (nM - fm) : WGM;
        u.pm = pm0 + fm + ((wgid % nig) % gsz); { const int v = (wgid % nig) / gsz; u.ks = v / nNr; u.pn = v - u.ks * nNr; } int e = 0;
#pragma unroll
        for (int k = 1; k < 8; ++k) e += (u.pm >= toff[k]) ? 1 : 0;
        int tb = 0;
#pragma unroll
        for (int k = 1; k < 8; ++k) tb = (u.pm >= toff[k]) ? toff[k] : tb;
        u.be = e; u.pa = atile > 0 ? e * atile + (u.pm - tb) : u.pm; return true;
    }
    __device__ __forceinline__ void a_ready(const Unit&) const {}
    __device__ __forceinline__ void done(const Unit&) const {}
};

template <class Epi, class Sched, bool ALIGN_EPI = false, bool SP2 = false, bool FP8 = false>
__device__ __forceinline__ void gemm_phase(PG8_LAS unsigned char* lds, const Gemm g, const Sched& S, const Epi& E) {
    int tid_ = threadIdx.x; asm volatile("" : "+v"(tid_));
    const int tid = tid_, wid = __builtin_amdgcn_readfirstlane(tid >> 6), lane = tid & 63, wr = wid >> 2, wc = wid & 3, fr = lane & 15, fq = lane >> 4;
    const int K = g.K, nt = g.KL / BK; const size_t kspl = (size_t)g.KL * 2;
    unsigned voffA[2], voffB[2];
#pragma unroll
    for (int i = 0; i < 2; ++i) { int R, C; stage_rc(tid * 16 + i * 8192, R, C); const int Rb = Epi::PERM ? ((R & ~31) + perm32(R & 31)) : R;
        voffA[i] = (unsigned)(R * K + C) * 2u; voffB[i] = (unsigned)(Rb * K + C) * 2u; }
    const size_t kstep = (size_t)(BK * 2);
    const size_t hstep = (size_t)HALF * K * 2;
    const size_t tstep = 2 * hstep;
    const unsigned ldsw = (unsigned)wid * 1024u;
    const int aoff = lds_byte(wr * 64 + fr, fq * 8), boff = lds_byte(wc * 32 + fr, fq * 8);
#define PG8_SA(b, h) (((b) * 2 + (h)) * HTB)
#define PG8_SB(b, h) ((4 + (b) * 2 + (h)) * HTB)
#define PG8_STAGE(bufoff, gbase, voff) do { _Pragma("unroll") for (int _i = 0; _i < 2; ++_i) \
        __builtin_amdgcn_global_load_lds((const unsigned*)((const char*)(gbase) + (voff)[_i]), (PG8_LAS unsigned*)(lds + (bufoff) + ldsw + _i * 8192), 16, 0, 0); } while (0)
#define PG8_LDA(dst, b, h) do { if constexpr (FP8) { _Pragma("unroll") for (int m = 0; m < 4; ++m) { dst##8[m].lo = *(const PG8_LAS i32x4*)(lds + PG8_SA(b, h) + aoff + m * 2048); dst##8[m].hi = *(const PG8_LAS i32x4*)(lds + PG8_SA(b, h) + aoff + m * 2048 + 1024); } } \
        else { _Pragma("unroll") for (int m = 0; m < 4; ++m) _Pragma("unroll") for (int k = 0; k < 2; ++k) dst[m][k] = *(const PG8_LAS bf16x8*)(lds + PG8_SA(b, h) + aoff + m * 2048 + k * 1024); } } while (0)
#define PG8_LDB(dst, b, h) do { if constexpr (FP8) { _Pragma("unroll") for (int n = 0; n < 2; ++n) { dst##8[n].lo = *(const PG8_LAS i32x4*)(lds + PG8_SB(b, h) + boff + n * 2048); dst##8[n].hi = *(const PG8_LAS i32x4*)(lds + PG8_SB(b, h) + boff + n * 2048 + 1024); } } \
        else { _Pragma("unroll") for (int n = 0; n < 2; ++n) _Pragma("unroll") for (int k = 0; k < 2; ++k) dst[n][k] = *(const PG8_LAS bf16x8*)(lds + PG8_SB(b, h) + boff + n * 2048 + k * 1024); } } while (0)
#define PG8_MMA(ai, bj, At, Bt) do { __builtin_amdgcn_s_setprio(1); _Pragma("unroll") for (int m = 0; m < 4; ++m) _Pragma("unroll") for (int n = 0; n < 2; ++n) { \
        if constexpr (FP8) { asm volatile("v_mfma_f32_16x16x128_f8f6f4 %0, %1, %2, %0" : "+v"(acc[ai][bj][m][n]) : "v"(Bt##8[n]), "v"(At##8[m])); }     \
        else { _Pragma("unroll") for (int k = 0; k < 2; ++k) acc[ai][bj][m][n] = __builtin_amdgcn_mfma_f32_16x16x32_bf16(Bt[n][k], At[m][k], acc[ai][bj][m][n], 0, 0, 0); } } __builtin_amdgcn_s_setprio(0); } while (0)
#define PG8_WAIT_V(n) asm volatile("s_waitcnt vmcnt(" #n ")" ::: "memory")
#define PG8_WAIT_L(n) asm volatile("s_waitcnt lgkmcnt(" #n ")" ::: "memory")
#define PG8_BAR __builtin_amdgcn_s_barrier()
#define PG8_SCHED __builtin_amdgcn_sched_barrier(0)
    Unit cur, nxt; int ui = 0;
    if (!S.next(0, cur)) return;
    f32x4 acc[2][2][4][2];
#pragma unroll
    for (int a = 0; a < 2; ++a)
#pragma unroll
        for (int b = 0; b < 2; ++b)
#pragma unroll
            for (int m = 0; m < 4; ++m)
#pragma unroll
                for (int n = 0; n < 2; ++n) acc[a][b][m][n] = (f32x4){0.f, 0.f, 0.f, 0.f};
    bf16x8 At[4][2], B0[2][2], B1[2][2];
    i32x8 At8[4], B08[2], B18[2];
    const char* cA = (const char*)g.A + (size_t)cur.pa * tstep + (size_t)cur.ks * kspl; const char* cB = (const char*)g.Bt + (size_t)cur.be * g.bstride + (size_t)cur.pn * tstep + (size_t)cur.ks * kspl;
    S.a_ready(cur);
    if constexpr (SP2) {
        PG8_STAGE(PG8_SB(0, 0), cB, voffB); PG8_STAGE(PG8_SB(0, 1), cB + hstep, voffB); PG8_STAGE(PG8_SA(0, 0), cA, voffA); PG8_STAGE(PG8_SA(0, 1), cA + hstep, voffA);
        if (wr == 1) PG8_BAR;
        PG8_WAIT_V(2); PG8_BAR;
        PG8_STAGE(PG8_SB(1, 0), cB + kstep, voffB); PG8_STAGE(PG8_SA(1, 0), cA + kstep, voffA); PG8_STAGE(PG8_SB(1, 1), cB + hstep + kstep, voffB);
        PG8_WAIT_V(6); PG8_BAR;
    } else {
        PG8_STAGE(PG8_SB(0, 0), cB, voffB); PG8_STAGE(PG8_SA(0, 0), cA, voffA); PG8_STAGE(PG8_SB(0, 1), cB + hstep, voffB); PG8_STAGE(PG8_SA(0, 1), cA + hstep, voffA);
        if (wr == 1) PG8_BAR;
        PG8_WAIT_V(4); PG8_BAR;
        PG8_STAGE(PG8_SB(1, 0), cB + kstep, voffB); PG8_STAGE(PG8_SA(1, 0), cA + kstep, voffA); PG8_STAGE(PG8_SB(1, 1), cB + hstep + kstep, voffB);
        PG8_WAIT_V(6); PG8_BAR;
    }
    for (;;) {
        const bool has_next = S.next(ui + 1, nxt);
        const char* nA = has_next ? (const char*)g.A + (size_t)nxt.pa * tstep + (size_t)nxt.ks * kspl : cA; const char* nB = has_next ? (const char*)g.Bt + (size_t)nxt.be * g.bstride + (size_t)nxt.pn * tstep + (size_t)nxt.ks * kspl : cB;
        for (int t = 0; t < nt; t += 2) {
            const bool last = (t == nt - 2);
            const char* a1 = cA + (size_t)(t + 1) * kstep;
            const char* a2 = last ? nA : cA + (size_t)(t + 2) * kstep; const char* b2 = last ? nB : cB + (size_t)(t + 2) * kstep;
            const char* a3 = a2 + kstep; const char* b3 = b2 + kstep;
            if (last && has_next) S.a_ready(nxt);
            if constexpr (SP2) {
            PG8_LDB(B0, 0, 0); PG8_LDB(B1, 0, 1); PG8_SCHED; PG8_LDA(At, 0, 0); PG8_STAGE(PG8_SA(1, 1), a1 + hstep, voffA);
            PG8_WAIT_V(8); PG8_WAIT_L(0); PG8_BAR; PG8_MMA(0, 0, At, B0); PG8_MMA(0, 1, At, B1); PG8_BAR; PG8_SCHED;
            PG8_LDA(At, 0, 1); PG8_STAGE(PG8_SB(0, 0), b2, voffB); PG8_STAGE(PG8_SB(0, 1), b2 + hstep, voffB); PG8_STAGE(PG8_SA(0, 0), a2, voffA);
            PG8_WAIT_V(8); PG8_WAIT_L(0); PG8_BAR; PG8_MMA(1, 0, At, B0); PG8_MMA(1, 1, At, B1); PG8_BAR; PG8_SCHED;
            PG8_LDB(B0, 1, 0); PG8_LDB(B1, 1, 1); PG8_SCHED; PG8_LDA(At, 1, 0); PG8_STAGE(PG8_SA(0, 1), a2 + hstep, voffA);
            PG8_WAIT_V(8); PG8_WAIT_L(0); PG8_BAR; PG8_MMA(0, 0, At, B0); PG8_MMA(0, 1, At, B1); PG8_BAR; PG8_SCHED;
            PG8_LDA(At, 1, 1); PG8_STAGE(PG8_SB(1, 0), b3, voffB); PG8_STAGE(PG8_SB(1, 1), b3 + hstep, voffB); PG8_STAGE(PG8_SA(1, 0), a3, voffA);
            PG8_WAIT_V(8); PG8_WAIT_L(0); PG8_BAR; PG8_MMA(1, 0, At, B0); PG8_MMA(1, 1, At, B1); PG8_BAR; PG8_SCHED;
            } else {
            PG8_LDB(B0, 0, 0); PG8_SCHED; PG8_LDA(At, 0, 0); PG8_STAGE(PG8_SA(1, 1), a1 + hstep, voffA);
            PG8_WAIT_L(8); PG8_BAR; PG8_WAIT_L(0); PG8_MMA(0, 0, At, B0); PG8_BAR; PG8_SCHED;
            PG8_LDB(B1, 0, 1); PG8_STAGE(PG8_SB(0, 0), b2, voffB);
            PG8_BAR; PG8_WAIT_L(0); PG8_MMA(0, 1, At, B1); PG8_BAR;
            PG8_LDA(At, 0, 1); PG8_STAGE(PG8_SA(0, 0), a2, voffA);
            PG8_BAR; PG8_WAIT_L(0); PG8_MMA(1, 0, At, B0); PG8_BAR; PG8_SCHED;
            PG8_STAGE(PG8_SB(0, 1), b2 + hstep, voffB);
            PG8_WAIT_V(6); PG8_BAR; PG8_MMA(1, 1, At, B1); PG8_BAR;
            PG8_LDB(B0, 1, 0); PG8_SCHED; PG8_LDA(At, 1, 0); PG8_STAGE(PG8_SA(0, 1), a2 + hstep, voffA);
            PG8_WAIT_L(8); PG8_BAR; PG8_WAIT_L(0); PG8_MMA(0, 0, At, B0); PG8_BAR; PG8_SCHED;
            PG8_LDB(B1, 1, 1); PG8_STAGE(PG8_SB(1, 0), b3, voffB);
            PG8_BAR; PG8_WAIT_L(0); PG8_MMA(0, 1, At, B1); PG8_BAR;
            PG8_LDA(At, 1, 1); PG8_STAGE(PG8_SA(1, 0), a3, voffA);
            PG8_BAR; PG8_WAIT_L(0); PG8_MMA(1, 0, At, B0); PG8_BAR; PG8_SCHED;
            PG8_STAGE(PG8_SB(1, 1), b3 + hstep, voffB);
            PG8_WAIT_V(6); PG8_BAR; PG8_MMA(1, 1, At, B1); PG8_BAR;
            }
        }
        if constexpr (ALIGN_EPI) { if (wr == 0) PG8_BAR; }
        if constexpr (FP8) { asm volatile("s_nop 15\n\ts_nop 15" ::: "memory"); }
        if constexpr (!Epi::AFTER_DRAIN) { E(acc, cur, wr, wc, fr, fq); S.done(cur); }
        if (!has_next) break;
#pragma unroll
        for (int a = 0; a < 2; ++a)
#pragma unroll
            for (int b = 0; b < 2; ++b)
#pragma unroll
                for (int m = 0; m < 4; ++m)
#pragma unroll
                    for (int n = 0; n < 2; ++n) acc[a][b][m][n] = (f32x4){0.f, 0.f, 0.f, 0.f};
        cur = nxt; cA = nA; cB = nB; ++ui;
        if constexpr (ALIGN_EPI) { if (wr == 1) PG8_BAR; }
    }
    PG8_WAIT_V(0);
    if constexpr (!ALIGN_EPI) { if (wr == 0) PG8_BAR; }
    PG8_BAR;
    if constexpr (Epi::AFTER_DRAIN) { E.fused(acc, cur, wr, wc, fr, fq, lds, wid, lane); S.done(cur); }
#undef PG8_SA
#undef PG8_SB
#undef PG8_STAGE
#undef PG8_LDA
#undef PG8_LDB
#undef PG8_MMA
#undef PG8_WAIT_V
#undef PG8_WAIT_L
#undef PG8_BAR
#undef PG8_SCHED
}
}
constexpr int NWAVES = 8;
constexpr int DM = 2048, SEQ = 8192, NBATCH = 2, CTXL = 256;
constexpr int ML = NBATCH * SEQ, MC = NBATCH * CTXL, MT = ML + MC;
constexpr int EIN = 4608, DFF = 5632, DFFE = 7168, NEXP = 8;
constexpr int MOD_W = 6 * DM;
constexpr int CAP = 2 * ML + NEXP * 256;
constexpr float NORM_EPS = 1e-6f;
constexpr int Y2_FULL_TILES = 128, Y2_PART_ROWS = 8 * 256;
static_assert((size_t)7 * Y2_PART_ROWS * DM * 2 <= (size_t)MT * DM * 2, "the partials fit the XN region");
constexpr int NCHUNK = ML / 64 + MC / 64;

constexpr size_t MiB = 1u << 20;
constexpr size_t al(size_t x) { return (x + MiB - 1) / MiB * MiB; }
constexpr size_t WS_CTL = 0, CTL_ZERO_BYTES = 1 * MiB;
constexpr size_t WS_MOD0 = 1 * MiB;
constexpr size_t WS_MOD1 = WS_MOD0 + 3 * MOD_W * 4;
constexpr size_t WS_ROPE = WS_MOD1 + 3 * MOD_W * 4;
constexpr size_t WS_ROUTE = 2 * MiB;
constexpr size_t WS_SUM = 3 * MiB;
constexpr size_t WS_CARRY = WS_SUM + al((size_t)NCHUNK * 2 * DM * 8);
constexpr size_t WS_HC = WS_CARRY + al((size_t)256 * 2 * DM * 4);
constexpr size_t WS_WIN0 = WS_HC + al((size_t)MC * DM * 4);
constexpr size_t WS_WOUT0 = WS_WIN0 + al((size_t)EIN * DM * 2);
constexpr size_t WS_WGU0 = WS_WOUT0 + al((size_t)DM * DM * 2);
constexpr size_t WS_WD0 = WS_WGU0 + al((size_t)2 * DFF * DM * 2);
constexpr size_t WS_WIN1 = WS_WD0 + al((size_t)DM * DFF * 2);
constexpr size_t WS_WGT = WS_WIN1 + al((size_t)2 * DM * DM * 2);
constexpr size_t WS_WOUT1 = WS_WGT + al((size_t)64 * 128 * 128 * 2);
constexpr size_t WS_MWGU = WS_WOUT1 + al((size_t)DM * DM * 2);
constexpr size_t WS_MWD = WS_MWGU + al((size_t)NEXP * 2 * DFFE * DM);
constexpr size_t WS_XN = WS_MWD + al((size_t)NEXP * DM * DFFE);
constexpr size_t WS_AO = WS_XN + al((size_t)MT * DM * 2);
constexpr size_t WS_VT = WS_AO + al((size_t)MT * DM * 2);
constexpr size_t WS_Z = WS_VT + al((size_t)(ML + MC) * 256 * 2);
constexpr size_t WS_HID = WS_Z + al((size_t)MT * EIN * 2);
constexpr size_t WS_H = WS_HID + al((size_t)CAP * DFFE * 2);
constexpr size_t WS_XGS = WS_H + al((size_t)MT * DM * 2);
constexpr size_t WS_END = WS_XGS + al((size_t)NEXP * ML * DM);
static_assert((size_t)CAP * DM * 2 <= (size_t)MT * EIN * 2, "XG fits the Z region");
static_assert(WS_Z - WS_XN >= (size_t)CAP * DM * 2, "split-K partial buffer 0 fits XN|AO|VT");
constexpr int CW_TMO = 0, CW_CODE = 1;
constexpr int CW_BAR = 4096;
constexpr int CW_BAR2 = 16384;
constexpr int CW_CNT = 8192;
constexpr int CW_QHEAD = 8256;
constexpr int CW_DONE = 8320;
constexpr int CW_W13 = 8320;

constexpr int RING_BYTES = 131072;
constexpr int SCR_BYTES = 151552;
constexpr int MISC_OFF = SCR_BYTES;
constexpr int LDS_BYTES = 155648;

#define GAS __attribute__((address_space(1)))
#define LAS __attribute__((address_space(3)))
typedef unsigned short bf16;
typedef unsigned v4u __attribute__((ext_vector_type(4)));
typedef unsigned v2u __attribute__((ext_vector_type(2)));
typedef float f32x4 __attribute__((ext_vector_type(4)));
typedef float f32x16 __attribute__((ext_vector_type(16)));
typedef short bf16x8 __attribute__((ext_vector_type(8)));
typedef GAS unsigned gu32;
#define RLX_AGENT __ATOMIC_RELAXED, __HIP_MEMORY_SCOPE_AGENT
#define LDS_WAIT() asm volatile("s_waitcnt lgkmcnt(0)" ::: "memory")
#define VM_WAIT() asm volatile("s_waitcnt vmcnt(0)" ::: "memory")
#define LDS_BARRIER() do { asm volatile("s_waitcnt lgkmcnt(0)" ::: "memory"); __builtin_amdgcn_s_barrier(); asm volatile("" ::: "memory"); } while (0)
__device__ __forceinline__ unsigned f2bf(float f) { unsigned u = __builtin_bit_cast(unsigned, f); return (u + 0x7fffu + ((u >> 16) & 1u)) >> 16; }
__device__ __forceinline__ unsigned pk2(float lo, float hi) { return pg8::cvt_pk_bf16(lo, hi); }
__device__ __forceinline__ float bflo(unsigned w) { return __builtin_bit_cast(float, w << 16); }
__device__ __forceinline__ float bfhi(unsigned w) { return __builtin_bit_cast(float, w & 0xffff0000u); }
__device__ __forceinline__ float wave_sum(float v) {
#pragma unroll
    for (int o = 1; o < 64; o <<= 1) v += __shfl_xor(v, o);
    return v;
}

#define XB_TMO      128
#define XB_XCNT(j)  (256  + 64 * (j))
#define XB_XSUB(j)  (1280 + 64 * (j))
#define XB_XGEN(j)  (2304 + 64 * (j))
#define XB_TOP      3328
#define XB_TOPGEN   3392
#define XCD_BAR_WORDS 3456
#define XB_SPIN_CAP (1u << 18)

__device__ __forceinline__ unsigned xb_ld(unsigned* p)              { return __hip_atomic_load(p, __ATOMIC_RELAXED, __HIP_MEMORY_SCOPE_AGENT); }
__device__ __forceinline__ unsigned xb_add(unsigned* p, unsigned v) { return __hip_atomic_fetch_add(p, v, __ATOMIC_RELAXED, __HIP_MEMORY_SCOPE_AGENT); }
__device__ __forceinline__ unsigned xb_xcc_id() { return (unsigned)__builtin_amdgcn_s_getreg((3 << 11) | 20) & 0xFu; }
#define XB_SPIN(cond, bar) do { unsigned _sp = 0; while (cond) { __builtin_amdgcn_s_sleep(1); \
    if ((++_sp & 255u) == 0u) { if (xb_ld(&(bar)[XB_TMO])) break; if (_sp > XB_SPIN_CAP) { atomicAdd(&(bar)[XB_TMO], 1u); break; } } } } while (0)

struct XcdBarrier {
    unsigned* bar; unsigned x; unsigned total;
    volatile LAS unsigned* st;
};

__device__ __forceinline__ XcdBarrier xcd_barrier_post(unsigned* bar, volatile LAS unsigned* st, unsigned total) {
    XcdBarrier b; b.bar = bar; b.x = xb_xcc_id(); b.st = st; b.total = total;
    if (threadIdx.x == 0) (void)xb_add(&bar[XB_XCNT(b.x)], 1u);
    return b;
}
__device__ __forceinline__ void xcd_barrier_complete(unsigned* bar, unsigned x, unsigned G, unsigned& nloc, unsigned& nx) {
    unsigned sum, cnt, mine, sp = 0u;
    for (;;) {
        sum = 0u; cnt = 0u; mine = 0u;
#pragma unroll
        for (unsigned j = 0; j < 16; ++j) { const unsigned c = xb_ld(&bar[XB_XCNT(j)]); sum += c; cnt += (c > 0u) ? 1u : 0u; mine = (j == x) ? c : mine; }
        if (sum == G) break;
        __builtin_amdgcn_s_sleep(1);
        if ((++sp & 255u) == 0u) { if (xb_ld(&bar[XB_TMO])) break; if (sp > XB_SPIN_CAP) { atomicAdd(&bar[XB_TMO], 1u); break; } }
    }
    nloc = mine > 0u ? mine : 1u; nx = cnt > 0u ? cnt : 1u;
}

__device__ __forceinline__ void xcd_barrier(const XcdBarrier& b) {
    asm volatile("s_waitcnt vmcnt(0)" ::: "memory");
    __syncthreads();
    if (threadIdx.x == 0) {
        unsigned* bar = b.bar;
        __builtin_amdgcn_s_waitcnt(0);
        unsigned nloc = b.st[0], nx = b.st[1];
        if (nloc == 0u) { xcd_barrier_complete(bar, b.x, b.total, nloc, nx); b.st[0] = nloc; b.st[1] = nx; }
        const unsigned old = xb_add(&bar[XB_XSUB(b.x)], 1u);
        const unsigned gen = old / nloc;
        if (old + 1u == (gen + 1u) * nloc) {
            __builtin_amdgcn_fence(__ATOMIC_RELEASE, "agent");
            asm volatile("s_waitcnt vmcnt(0)" ::: "memory");
            const unsigned og = xb_add(&bar[XB_TOP], 1u);
            const unsigned tg = og / nx;
            if (og + 1u == (tg + 1u) * nx) xb_add(&bar[XB_TOPGEN], 1u);
            else XB_SPIN(xb_ld(&bar[XB_TOPGEN]) == tg, bar);
            __builtin_amdgcn_fence(__ATOMIC_ACQUIRE, "agent");
            xb_add(&bar[XB_XGEN(b.x)], 1u);
            asm volatile("s_waitcnt vmcnt(0)" ::: "memory");
        } else {
            XB_SPIN(xb_ld(&bar[XB_XGEN(b.x)]) == gen, bar);
            __builtin_amdgcn_fence(__ATOMIC_ACQUIRE, "agent");
            asm volatile("s_waitcnt vmcnt(0)" ::: "memory");
        }
    }
    __syncthreads();
}

struct Args { const float* in[35]; float* out; unsigned char* ws; int ph_lo, ph_hi; };
struct Frame {
    LAS unsigned char* lds;
    gu32* ctl;
    int tid, lane, wave, vcu, G;
    const float* const* in; float* out; unsigned char* ws;
};
#define WSP(T, off) ((T*)(F.ws + (off)))

__device__ __forceinline__ void tr_item(const float* W, int ldw, int k0, int n0, bf16* WT, int ldt, int dst_row0, LAS float* scr, int lane) {
    const int rr = lane >> 4, c4 = (lane & 15) * 4;
    f32x4 v[16];
#pragma unroll
    for (int i = 0; i < 16; ++i) v[i] = *(const GAS f32x4*)(W + (size_t)(k0 + 4 * i + rr) * ldw + n0 + c4);
#pragma unroll
    for (int i = 0; i < 16; ++i) { LAS float* p = scr + (4 * i + rr) * 65 + c4; p[0] = v[i].x; p[1] = v[i].y; p[2] = v[i].z; p[3] = v[i].w; }
    LDS_WAIT(); asm volatile("" ::: "memory");
    const int kc = lane & 7, nn = lane >> 3;
#pragma unroll
    for (int j = 0; j < 8; ++j) { const int n = nn + 8 * j; const LAS float* s = scr + (8 * kc) * 65 + n;
        v4u o; o.x = pk2(s[0 * 65], s[1 * 65]); o.y = pk2(s[2 * 65], s[3 * 65]); o.z = pk2(s[4 * 65], s[5 * 65]); o.w = pk2(s[6 * 65], s[7 * 65]);
        *(GAS v4u*)(WT + (size_t)(dst_row0 + n) * ldt + k0 + 8 * kc) = o; }
    LDS_WAIT(); asm volatile("" ::: "memory");
}
__device__ __forceinline__ void tr_matrix_item(const float* W, int K, int N, bf16* WT, int mode, int item, LAS float* scr, int lane) {
    const int nb = N / 64, kb = item / nb, nbi = item % nb, k0 = kb * 64, n0 = nbi * 64;
    const int dr = mode == 0 ? n0 : (256 * (n0 >> 7) + (n0 & 127) + (mode == 2 ? 128 : 0));
    tr_item(W, N, k0, n0, WT, K, dr, scr, lane);
}
__device__ __forceinline__ float silu_f(float x) { return x / (1.0f + __expf(-x)); }
__device__ __forceinline__ void adaln_item(Frame& F, const float* wmod, const float* bmod, float* mod, int slab) {
    const float* c = F.in[1]; const float* cc = F.in[3];
    const int c4 = F.tid & 31, kg = F.tid >> 5, n0 = slab * 128 + c4 * 4;
    LAS float* sl = (LAS float*)(F.lds + 32768);
    for (int i = F.tid; i < 3 * DM; i += NWAVES * 64) { const float x = i < 2 * DM ? c[i] : cc[i - 2 * DM]; sl[i] = silu_f(x); }
    __syncthreads();
    f32x4 a0 = {0.f, 0.f, 0.f, 0.f}, a1 = a0, a2 = a0;
#pragma unroll 16
    for (int i = 0; i < 128; ++i) { const int k = kg + 16 * i; const f32x4 w = __builtin_nontemporal_load((const GAS f32x4*)(wmod + (size_t)k * MOD_W + n0));
        const float s0 = sl[k], s1 = sl[DM + k], s2 = sl[2 * DM + k]; a0 += w * s0; a1 += w * s1; a2 += w * s2; }
    LAS float* red = (LAS float*)F.lds;
    *(LAS f32x4*)(red + (kg * 3 + 0) * 128 + c4 * 4) = a0; *(LAS f32x4*)(red + (kg * 3 + 1) * 128 + c4 * 4) = a1; *(LAS f32x4*)(red + (kg * 3 + 2) * 128 + c4 * 4) = a2;
    __syncthreads();
    if (F.tid < 384) { const int v = F.tid >> 7, col = F.tid & 127; float s = bmod[slab * 128 + col];
#pragma unroll
        for (int g = 0; g < 16; ++g) s += red[(g * 3 + v) * 128 + col];
        mod[(size_t)v * MOD_W + slab * 128 + col] = s; }
    __syncthreads();
}
constexpr int I_WIN0 = 32 * 72, I_SQ = 32 * 32, I_F = 32 * 88, I_WIN1 = 32 * 64, I_G = 4, I_ME = 32 * 112;
constexpr int NDENSE = I_WIN0 + I_SQ + 3 * I_F + I_WIN1 + I_SQ + 64 * I_G, NITEMS = NDENSE + 24 * I_ME;
#ifndef MK_FFN8
#define MK_FFN8 1
#endif
constexpr int FFN8 = MK_FFN8;
struct CvItem { const float* src; bf16* dst; int ldw, ldt, f8; };
constexpr float W8_SCALE = 64.0f;
__device__ __forceinline__ unsigned pk4_fp8(float a, float b, float c, float d) { int p = 0; p = __builtin_amdgcn_cvt_pk_fp8_f32(a, b, p, false); p = __builtin_amdgcn_cvt_pk_fp8_f32(c, d, p, true); return (unsigned)p; }
__device__ __forceinline__ float clamp8(float x) { return __builtin_fminf(__builtin_fmaxf(x, -448.0f), 448.0f); }
__device__ __forceinline__ CvItem cv_make(const float* W, int K, int N, bf16* WT, int mode, int sub, int f8 = 0) {
    const int nb = N / 32, kb = sub / nb, nbi = sub % nb, k0 = kb * 128, n0 = nbi * 32;
    const int dr = mode == 0 ? n0 : (256 * (n0 >> 7) + (n0 & 127) + (mode == 2 ? 128 : 0));
    CvItem m; m.src = W + (size_t)k0 * N + n0; m.ldw = N; m.f8 = f8;
    if (f8) { m.dst = (bf16*)((unsigned char*)WT + (size_t)dr * K + k0); m.ldt = K; } else { m.dst = WT + (size_t)dr * K + k0; m.ldt = K; }
    return m;
}
__device__ __forceinline__ CvItem cv_item(Frame& F, int it) {
    int r = it;
    if (r < I_WIN0) return cv_make(F.in[7], DM, EIN, WSP(bf16, WS_WIN0), 0, r); r -= I_WIN0;
    if (r < I_SQ) return cv_make(F.in[11], DM, DM, WSP(bf16, WS_WOUT0), 0, r); r -= I_SQ;
    if (r < I_F) return cv_make(F.in[13], DM, DFF, WSP(bf16, WS_WGU0), 1, r, FFN8); r -= I_F;
    if (r < I_F) return cv_make(F.in[14], DM, DFF, WSP(bf16, WS_WGU0), 2, r, FFN8); r -= I_F;
    if (r < I_F) return cv_make(F.in[15], DFF, DM, WSP(bf16, WS_WD0), 0, r, FFN8); r -= I_F;
    if (r < I_WIN1) return cv_make(F.in[19], DM, 2 * DM, WSP(bf16, WS_WIN1), 0, r); r -= I_WIN1;
    if (r < I_SQ) return cv_make(F.in[27], DM, DM, WSP(bf16, WS_WOUT1), 0, r); r -= I_SQ;
    if (r < 64 * I_G) { const int mtx = r >> 2, sub = r & 3, gt = mtx >> 5, zh = mtx & 31, z = zh >> 4, h = zh & 15;
        return cv_make(F.in[gt ? 24 : 22] + (size_t)zh * 16384, 128, 128, WSP(bf16, WS_WGT) + (size_t)((z * 2 + gt) * 16 + h) * 16384, 0, sub); } r -= 64 * I_G;
    const int w = r / (8 * I_ME), rr = r % (8 * I_ME), e = rr / I_ME, sub = rr % I_ME;
    if (w == 0) return cv_make(F.in[31] + (size_t)e * DM * DFFE, DM, DFFE, (bf16*)(F.ws + WS_MWGU + (size_t)e * 2 * DFFE * DM), 1, sub, 1);
    if (w == 1) return cv_make(F.in[32] + (size_t)e * DM * DFFE, DM, DFFE, (bf16*)(F.ws + WS_MWGU + (size_t)e * 2 * DFFE * DM), 2, sub, 1);
    return cv_make(F.in[33] + (size_t)e * DFFE * DM, DFFE, DM, (bf16*)(F.ws + WS_MWD + (size_t)e * DM * DFFE), 0, sub, 1);
}
__device__ __forceinline__ void cv_load(const CvItem& m, int lane, f32x4 (&v)[16]) {
    const int rr = lane >> 3, c4 = (lane & 7) * 4;
#pragma unroll
    for (int i = 0; i < 16; ++i) v[i] = __builtin_nontemporal_load((const GAS f32x4*)(m.src + (size_t)(8 * i + rr) * m.ldw + c4));
}
__device__ __forceinline__ float clamp8s(float x) { return __builtin_amdgcn_fmed3f(x * W8_SCALE, -448.0f, 448.0f); }
__device__ __forceinline__ void cv_finish(const CvItem& m, int lane, const f32x4 (&v)[16], LAS float* scr) {
    const int rr = lane >> 3, c4 = (lane & 7) * 4;
#pragma unroll
    for (int i = 0; i < 16; ++i) *(LAS f32x4*)(scr + (8 * i + rr) * 36 + (c4 ^ (4 * ((i >> 1) & 7)))) = v[i];
    LDS_WAIT(); asm volatile("" ::: "memory");
    const int kc = lane & 7, nn = lane >> 3;
#pragma unroll
    for (int j = 0; j < 4; ++j) { const int n = nn + 8 * j; const LAS float* s = scr + (16 * kc) * 36 + (n ^ (4 * kc));
        float x[16];
#pragma unroll
        for (int q = 0; q < 16; ++q) x[q] = s[q * 36];
        if (m.f8) { v4u o;
            o.x = pk4_fp8(clamp8s(x[0]), clamp8s(x[1]), clamp8s(x[2]), clamp8s(x[3])); o.y = pk4_fp8(clamp8s(x[4]), clamp8s(x[5]), clamp8s(x[6]), clamp8s(x[7]));
            o.z = pk4_fp8(clamp8s(x[8]), clamp8s(x[9]), clamp8s(x[10]), clamp8s(x[11])); o.w = pk4_fp8(clamp8s(x[12]), clamp8s(x[13]), clamp8s(x[14]), clamp8s(x[15]));
            __builtin_nontemporal_store(o, (GAS v4u*)((unsigned char*)m.dst + (size_t)n * m.ldt + 16 * kc)); }
        else { v4u o0, o1; o0.x = pk2(x[0], x[1]); o0.y = pk2(x[2], x[3]); o0.z = pk2(x[4], x[5]); o0.w = pk2(x[6], x[7]); o1.x = pk2(x[8], x[9]); o1.y = pk2(x[10], x[11]); o1.z = pk2(x[12], x[13]); o1.w = pk2(x[14], x[15]);
            GAS v4u* d = (GAS v4u*)(m.dst + (size_t)n * m.ldt + 16 * kc); __builtin_nontemporal_store(o0, d); __builtin_nontemporal_store(o1, d + 1); } }
    LDS_WAIT(); asm volatile("" ::: "memory");
}
constexpr int NEARLY = I_WIN0 + I_SQ + 3 * I_F;
constexpr int NQ = NITEMS - NEARLY, NQ_LATE = I_WIN1 + I_SQ + 64 * I_G;
__device__ __forceinline__ void convert_dense(Frame& F) {
    LAS float* scr = (LAS float*)(F.lds + F.wave * 18432);
    const int NW = F.G * NWAVES; int r = F.vcu * NWAVES + F.wave;
    f32x4 va[16], vb[16]; CvItem ma, mb;
    if (r < NEARLY) { ma = cv_item(F, r); cv_load(ma, F.lane, va); }
#pragma unroll 1
    for (; r < NEARLY; r += 2 * NW) {
        const bool hb = r + NW < NEARLY;
        if (hb) { mb = cv_item(F, r + NW); cv_load(mb, F.lane, vb); }
        cv_finish(ma, F.lane, va, scr);
        if (r + 2 * NW < NEARLY) { ma = cv_item(F, r + 2 * NW); cv_load(ma, F.lane, va); }
        if (hb) cv_finish(mb, F.lane, vb, scr);
    }
}
__device__ __forceinline__ void moe_pull(Frame& F, int k, int until) {
    LAS int* q = (LAS int*)(F.lds + MISC_OFF + 64);
    LAS float* scr = (LAS float*)(F.lds + F.wave * 18432);
    gu32* qhead = F.ctl + CW_QHEAD; gu32* done = F.ctl + CW_DONE + 64 * (k < 0 ? 0 : k);
    bool first = true;
    for (;;) {
        __syncthreads();
        if (F.tid == 0) {
            if (first && k >= 0) __hip_atomic_fetch_add(done, 1u, RLX_AGENT);
            const bool go = k < 0 ? (int)__hip_atomic_load(qhead, RLX_AGENT) < until : (int)__hip_atomic_load(done, RLX_AGENT) < F.G;
            int f = -1; if (go) { f = (int)__hip_atomic_fetch_add(qhead, 64u, RLX_AGENT); if (f >= NQ) f = -1; }
            q[0] = f;
        }
        first = false;
        __syncthreads();
        const int f0 = q[0];
        if (f0 < 0) break;
        const int f = f0 + 8 * F.wave;
        f32x4 va[16], vb[16]; CvItem ma, mb;
        if (f < NQ) { ma = cv_item(F, NEARLY + f); cv_load(ma, F.lane, va); }
#pragma unroll 1
        for (int t = 0; t < 8; t += 2) {
            if (f + t + 1 < NQ) { mb = cv_item(F, NEARLY + f + t + 1); cv_load(mb, F.lane, vb); }
            if (f + t < NQ) cv_finish(ma, F.lane, va, scr);
            if (t + 2 < 8 && f + t + 2 < NQ) { ma = cv_item(F, NEARLY + f + t + 2); cv_load(ma, F.lane, va); }
            if (f + t + 1 < NQ) cv_finish(mb, F.lane, vb, scr);
        }
    }
}
__device__ __forceinline__ void p0_prologue(Frame& F) {
    for (int it = F.vcu; it < 192; it += F.G) { const int layer = it / 96, slab = it % 96;
        adaln_item(F, F.in[layer ? 16 : 4], F.in[layer ? 17 : 5], WSP(float, layer ? WS_MOD1 : WS_MOD0), slab); }
    { const int gt = F.vcu * 512 + F.tid; if (gt < 192 * 32) { const int pos = gt >> 5, i = gt & 31; const float inv = powf(10000.0f, -(float)i / 32.0f);
        const float ang = (float)(pos < 128 ? pos : pos - 128) * inv; float* rp = WSP(float, WS_ROPE); rp[gt] = cosf(ang); rp[192 * 32 + gt] = sinf(ang); } }
    __syncthreads();
    convert_dense(F);
}

template <bool F8, bool SRCH = false> __device__ __forceinline__ void norm_phase(Frame& F, const float* srcL, const float* srcC, const float* g, const float* mod, int shift_off, int scale_off, int nrows) {
    const int gw = F.vcu * NWAVES + F.wave, NGW = F.G * NWAVES;
    bf16* XN = WSP(bf16, WS_XN);
    for (int row = gw; row < nrows; row += NGW) {
        const float* src = row < ML ? srcL + (size_t)row * DM : srcC + (size_t)(row - ML) * DM;
        const float* mv = mod + (size_t)(row < ML ? (row >> 13) : 2) * MOD_W;
        const GAS f32x4* xr = (const GAS f32x4*)src + F.lane;
        f32x4 v[8]; float s = 0.f;
#pragma unroll
        for (int j = 0; j < 8; ++j) {
            if constexpr (SRCH) { const v2u w = ((const GAS v2u*)(WSP(const bf16, WS_H) + (size_t)row * DM))[F.lane + 64 * j]; v[j].x = bflo(w.x); v[j].y = bfhi(w.x); v[j].z = bflo(w.y); v[j].w = bfhi(w.y); }
            else v[j] = xr[64 * j];
            s += (v[j].x * v[j].x + v[j].y * v[j].y) + (v[j].z * v[j].z + v[j].w * v[j].w); }
        const float rstd = 1.0f / sqrtf(wave_sum(s) * (1.0f / DM) + NORM_EPS);
        GAS v2u* o8 = (GAS v2u*)(XN + (size_t)row * DM) + F.lane;
#pragma unroll
        for (int j = 0; j < 8; ++j) { const int col = 4 * (F.lane + 64 * j);
            const f32x4 gg = *(const GAS f32x4*)(g + col), sh = *(const GAS f32x4*)(mv + shift_off + col), sc = *(const GAS f32x4*)(mv + scale_off + col);
            const f32x4 y = v[j] * rstd * gg * (sc + 1.0f) + sh;
            if (F8) { ((GAS unsigned*)((unsigned char*)XN + (size_t)row * DM))[F.lane + 64 * j] = pk4_fp8(clamp8(y.x), clamp8(y.y), clamp8(y.z), clamp8(y.w)); }
            else { v2u w; w.x = pk2(y.x, y.y); w.y = pk2(y.z, y.w); o8[64 * j] = w; } }
    }
}
__device__ __forceinline__ void rope_conv_phase(Frame& F) {
    const int gw = F.vcu * NWAVES + F.wave, NGW = F.G * NWAVES;
    bf16* Z = WSP(bf16, WS_Z); bf16* AO = WSP(bf16, WS_AO); const float* rope = WSP(const float, WS_ROPE);
    const float* cw = F.in[9]; const float* cb = F.in[10];
    for (int row = gw; row < MT; row += NGW) {
        bf16* zr = Z + (size_t)row * EIN;
        if (row < ML) {
            const int t = row & (SEQ - 1);
#pragma unroll
            for (int ps = 0; ps < 3; ++ps) { const int li = ps * 64 + F.lane;
                if (li < 160) { const int hd = li >> 4, sub = li & 15, half = sub >> 3, d4 = (sub & 7) * 4;
                    const int col = (hd < 8 ? hd * 128 : 1024 + (hd - 8) * 128) + half * 64 + d4;
                    const int pos = half ? 128 + (t & 63) : (t >> 6);
                    const f32x4 cs = *(const GAS f32x4*)(rope + pos * 32 + d4), sn = *(const GAS f32x4*)(rope + 192 * 32 + pos * 32 + d4);
                    const v2u a = *(const GAS v2u*)(zr + col), b = *(const GAS v2u*)(zr + col + 32);
                    const float x0 = bflo(a.x), x1 = bfhi(a.x), x2 = bflo(a.y), x3 = bfhi(a.y), y0 = bflo(b.x), y1 = bfhi(b.x), y2 = bflo(b.y), y3 = bfhi(b.y);
                    v2u oa, ob; oa.x = pk2(x0 * cs.x - y0 * sn.x, x1 * cs.y - y1 * sn.y); oa.y = pk2(x2 * cs.z - y2 * sn.z, x3 * cs.w - y3 * sn.w);
                    ob.x = pk2(y0 * cs.x + x0 * sn.x, y1 * cs.y + x1 * sn.y); ob.y = pk2(y2 * cs.z + x2 * sn.z, y3 * cs.w + x3 * sn.w);
                    *(GAS v2u*)(zr + col) = oa; *(GAS v2u*)(zr + col + 32) = ob; } }
        }
        const int tt = row < ML ? (row & (SEQ - 1)) : ((row - ML) & (CTXL - 1)); const int tlen = row < ML ? SEQ : CTXL;
        const bool hp = tt > 0, hn = tt < tlen - 1;
#pragma unroll
        for (int ps = 0; ps < 2; ++ps) { const int ch = (ps * 64 + F.lane) * 8;
            const v4u z4 = {0u, 0u, 0u, 0u};
            const v4u xc_ = *(const GAS v4u*)(zr + 1536 + ch), gc_ = *(const GAS v4u*)(zr + 3584 + ch), bg = *(const GAS v4u*)(zr + 2560 + ch);
            const v4u xp = hp ? *(const GAS v4u*)(zr - EIN + 1536 + ch) : z4, gp = hp ? *(const GAS v4u*)(zr - EIN + 3584 + ch) : z4;
            const v4u xn = hn ? *(const GAS v4u*)(zr + EIN + 1536 + ch) : z4, gn = hn ? *(const GAS v4u*)(zr + EIN + 3584 + ch) : z4;
            float o[8];
#pragma unroll
            for (int j = 0; j < 4; ++j) {
#pragma unroll
                for (int e = 0; e < 2; ++e) { const int c = ch + 2 * j + e;
                    const float up = e ? bfhi(xp[j]) * bfhi(gp[j]) : bflo(xp[j]) * bflo(gp[j]);
                    const float uc = e ? bfhi(xc_[j]) * bfhi(gc_[j]) : bflo(xc_[j]) * bflo(gc_[j]);
                    const float un = e ? bfhi(xn[j]) * bfhi(gn[j]) : bflo(xn[j]) * bflo(gn[j]);
                    const float bgv = e ? bfhi(bg[j]) : bflo(bg[j]);
                    o[2 * j + e] = bgv * (cb[c] + cw[c] * up + cw[1024 + c] * uc + cw[2048 + c] * un); } }
            v4u w; w.x = pk2(o[0], o[1]); w.y = pk2(o[2], o[3]); w.z = pk2(o[4], o[5]); w.w = pk2(o[6], o[7]);
            *(GAS v4u*)(AO + (size_t)row * DM + 1024 + ch) = w; }
    }
    LAS unsigned short* scr = (LAS unsigned short*)(F.lds + F.wave * 16640);
    bf16* VT = WSP(bf16, WS_VT);
    for (int it = gw; it < (MT / 64) * 2; it += NGW) { const int kvh = it & 1, blk = it >> 1, row0 = blk * 64;
        const int rr = F.lane >> 4, c8 = (F.lane & 15) * 8;
#pragma unroll
        for (int i = 0; i < 16; ++i) { const v4u v = *(const GAS v4u*)(Z + (size_t)(row0 + 4 * i + rr) * EIN + 1280 + kvh * 128 + c8);
            LAS unsigned* p = (LAS unsigned*)(scr + (4 * i + rr) * 130 + c8); p[0] = v.x; p[1] = v.y; p[2] = v.z; p[3] = v.w; }
        LDS_WAIT(); asm volatile("" ::: "memory");
        const bool isc = row0 >= ML; const int bb = isc ? (row0 - ML) >> 8 : row0 >> 13, t0 = isc ? (row0 - ML) & 255 : row0 & (SEQ - 1), tl = isc ? CTXL : SEQ;
        bf16* dst = VT + (isc ? (size_t)ML * 256 : 0) + (size_t)(bb * 2 + kvh) * 128 * tl + t0;
        const int tc = F.lane & 7, dd = F.lane >> 3;
#pragma unroll
        for (int j = 0; j < 16; ++j) { const int d = dd + 8 * j; const LAS unsigned short* s = scr + (8 * tc) * 130 + d;
            v4u o; o.x = (unsigned)s[0] | ((unsigned)s[130] << 16); o.y = (unsigned)s[2 * 130] | ((unsigned)s[3 * 130] << 16);
            o.z = (unsigned)s[4 * 130] | ((unsigned)s[5 * 130] << 16); o.w = (unsigned)s[6 * 130] | ((unsigned)s[7 * 130] << 16);
            *(GAS v4u*)(dst + (size_t)d * tl + 8 * tc) = o; }
        LDS_WAIT(); asm volatile("" ::: "memory");
    }
}

__device__ __forceinline__ int crow(int r, int hh) { return (r & 3) + 8 * (r >> 2) + 4 * hh; }
__device__ __forceinline__ bool attn_tile_ok(int i, int qb) { if (i < 4) return true; const int ks = qb * 64 - 128 + 64 * (i - 4); return ks >= 0 && ks < SEQ; }
__device__ __forceinline__ void attn_issue(const bf16* Z, const bf16* VT, int i, int b, int kvh, int qb, int tid, v4u (&kreg)[2], v4u (&vreg)[2]) {
    const bf16* kbase; const bf16* vbase; int tl;
    if (i < 4) { kbase = Z + (size_t)(ML + b * CTXL + 64 * i) * EIN + 1024 + kvh * 128; vbase = VT + (size_t)ML * 256 + (size_t)(b * 2 + kvh) * 128 * CTXL + 64 * i; tl = CTXL; }
    else { const int ks = qb * 64 - 128 + 64 * (i - 4); kbase = Z + (size_t)(b * SEQ + ks) * EIN + 1024 + kvh * 128; vbase = VT + (size_t)(b * 2 + kvh) * 128 * SEQ + ks; tl = SEQ; }
#pragma unroll
    for (int e = 0; e < 2; ++e) { const int id = tid + 512 * e;
        kreg[e] = *(const GAS v4u*)(kbase + (size_t)(id >> 4) * EIN + (id & 15) * 8);
        vreg[e] = *(const GAS v4u*)(vbase + (size_t)(id >> 3) * tl + (id & 7) * 8); }
}
__device__ __forceinline__ void attn_phase(Frame& F) {
    const bf16* Z = WSP(const bf16, WS_Z); const bf16* VT = WSP(const bf16, WS_VT); bf16* AO = WSP(bf16, WS_AO);
    const float* sinks = F.in[8];
    LAS unsigned char* KL = F.lds; LAS unsigned char* VL = F.lds + 17408;
    const int r = F.lane & 31, hh = F.lane >> 5, g = F.wave >> 1, qs = (F.wave & 1) * 32;
    constexpr float CSC = 0.08838834764831845f * 1.4426950408889634f;
    for (int u = F.vcu; u < 528; u += F.G) {
        const bool isc = u >= 512; int b, kvh, qb;
        if (!isc) { b = u >> 8; kvh = (u >> 7) & 1; qb = u & 127; } else { const int v = u - 512; b = v >> 3; kvh = (v >> 2) & 1; qb = v & 3; }
        const int qrow0 = isc ? ML + b * CTXL + qb * 64 : b * SEQ + qb * 64, head = kvh * 4 + g;
        bf16x8 qf[8];
        { const bf16* qp = Z + (size_t)(qrow0 + qs + r) * EIN + head * 128 + 8 * hh;
#pragma unroll
          for (int s = 0; s < 8; ++s) qf[s] = *(const GAS bf16x8*)(qp + 16 * s); }
        const float tsink = sinks[head] * 1.4426950408889634f;
        float m = tsink, l = 0.f;
        f32x16 o[4];
#pragma unroll
        for (int dg = 0; dg < 4; ++dg)
#pragma unroll
            for (int i = 0; i < 16; ++i) o[dg][i] = 0.f;
        const int ntile = isc ? 4 : 9;
        v4u kreg[2][2], vreg[2][2];
        int tcur = 0, tnxt = 1; while (tnxt < ntile && !attn_tile_ok(tnxt, qb)) ++tnxt;
        attn_issue(Z, VT, tcur, b, kvh, qb, F.tid, kreg[0], vreg[0]);
        if (tnxt < ntile) attn_issue(Z, VT, tnxt, b, kvh, qb, F.tid, kreg[1], vreg[1]);
        bool more = true;
        while (more) {
#pragma unroll
          for (int hs = 0; hs < 2; ++hs) { if (more) {
            const int cur = tcur;
            LDS_BARRIER();
#pragma unroll
            for (int e = 0; e < 2; ++e) { const int id = F.tid + 512 * e;
                *(LAS v4u*)(KL + (id >> 4) * 272 + (id & 15) * 16) = kreg[hs][e];
                LAS v2u* vp = (LAS v2u*)(VL + (id >> 3) * 136 + (id & 7) * 16); v2u lo, hi; lo.x = vreg[hs][e].x; lo.y = vreg[hs][e].y; hi.x = vreg[hs][e].z; hi.y = vreg[hs][e].w; vp[0] = lo; vp[1] = hi; }
            LDS_BARRIER();
            int t2 = tnxt + 1; while (t2 < ntile && !attn_tile_ok(t2, qb)) ++t2;
            if (tnxt < ntile && t2 < ntile) attn_issue(Z, VT, t2, b, kvh, qb, F.tid, kreg[hs], vreg[hs]);
            f32x16 sc[2];
#pragma unroll
            for (int kg = 0; kg < 2; ++kg) {
#pragma unroll
                for (int i = 0; i < 16; ++i) sc[kg][i] = 0.f;
#pragma unroll
                for (int s = 0; s < 8; ++s) { const bf16x8 kf = *(const LAS bf16x8*)(KL + (32 * kg + r) * 272 + (16 * s + 8 * hh) * 2);
                    sc[kg] = __builtin_amdgcn_mfma_f32_32x32x16_bf16(kf, qf[s], sc[kg], 0, 0, 0); } }
            const int mode = (cur == 4) ? 1 : (cur == 8 ? 2 : 0);
            float tmax = -3.0e38f;
#pragma unroll
            for (int kg = 0; kg < 2; ++kg)
#pragma unroll
                for (int i = 0; i < 16; ++i) { float t = sc[kg][i] * CSC; const int kk = 32 * kg + crow(i, hh), qq = qs + r;
                    if ((mode == 1 && kk < qq) || (mode == 2 && kk > qq)) t = -1.0e30f;
                    sc[kg][i] = t; tmax = fmaxf(tmax, t); }
            tmax = fmaxf(tmax, __shfl_xor(tmax, 32));
            const float mn = fmaxf(m, tmax), alpha = __builtin_amdgcn_exp2f(m - mn); m = mn;
            float ps = 0.f;
#pragma unroll
            for (int kg = 0; kg < 2; ++kg)
#pragma unroll
                for (int i = 0; i < 16; ++i) { const float p = __builtin_amdgcn_exp2f(sc[kg][i] - m); sc[kg][i] = p; ps += p; }
            l = l * alpha + ps;
#pragma unroll
            for (int dg = 0; dg < 4; ++dg)
#pragma unroll
                for (int i = 0; i < 16; ++i) o[dg][i] *= alpha;
#pragma unroll
            for (int kg = 0; kg < 2; ++kg)
#pragma unroll
                for (int s2 = 0; s2 < 2; ++s2) { v4u pw; pw.x = pk2(sc[kg][8 * s2 + 0], sc[kg][8 * s2 + 1]); pw.y = pk2(sc[kg][8 * s2 + 2], sc[kg][8 * s2 + 3]);
                    pw.z = pk2(sc[kg][8 * s2 + 4], sc[kg][8 * s2 + 5]); pw.w = pk2(sc[kg][8 * s2 + 6], sc[kg][8 * s2 + 7]);
                    const bf16x8 pf = __builtin_bit_cast(bf16x8, pw);
#pragma unroll
                    for (int dg = 0; dg < 4; ++dg) { const LAS unsigned char* vb = VL + (32 * dg + r) * 136 + (32 * kg + 16 * s2 + 4 * hh) * 2;
                        const v2u lo = *(const LAS v2u*)vb, hi = *(const LAS v2u*)(vb + 16); v4u vw; vw.x = lo.x; vw.y = lo.y; vw.z = hi.x; vw.w = hi.y;
                        o[dg] = __builtin_amdgcn_mfma_f32_32x32x16_bf16(__builtin_bit_cast(bf16x8, vw), pf, o[dg], 0, 0, 0); } }
            more = tnxt < ntile; tcur = tnxt; tnxt = t2;
          } }
        }
        const float lt = l + __shfl_xor(l, 32) + __builtin_amdgcn_exp2f(tsink - m), inv = 1.0f / lt;
        bf16* op = AO + (size_t)(qrow0 + qs + r) * DM + head * 128;
#pragma unroll
        for (int dg = 0; dg < 4; ++dg)
#pragma unroll
            for (int g4 = 0; g4 < 4; ++g4) { v2u w; w.x = pk2(o[dg][4 * g4 + 0] * inv, o[dg][4 * g4 + 1] * inv); w.y = pk2(o[dg][4 * g4 + 2] * inv, o[dg][4 * g4 + 3] * inv);
                *(GAS v2u*)(op + 32 * dg + 8 * g4 + 4 * hh) = w; }
    }
}
template <bool FINAL, int z> __device__ __forceinline__ void rglru_blocks(LAS unsigned char* XCB, LAS float* XCF, LAS float* HS, const bf16x8 (&wa)[8], const bf16x8 (&wx)[8],
        float ba, float bxx, float sp8, int r, int hh, int chl, float& st, float& CA, float& CB) {
#pragma unroll
        for (int bi = 0; bi < 2; ++bi) { const int tb = z ? 1 - bi : bi;
            if (z == 1 && bi == 0) __builtin_amdgcn_s_sleep(8);
            f32x16 ya, yx;
#pragma unroll
            for (int i = 0; i < 16; ++i) { ya[i] = ba; yx[i] = bxx; }
#pragma unroll
            for (int s = 0; s < 8; ++s) { const bf16x8 af = *(const LAS bf16x8*)(XCB + (32 * tb + r) * 272 + (16 * s + 8 * hh) * 2);
                ya = __builtin_amdgcn_mfma_f32_32x32x16_bf16(af, wa[s], ya, 0, 0, 0); yx = __builtin_amdgcn_mfma_f32_32x32x16_bf16(af, wx[s], yx, 0, 0, 0); }
            float av[16], bv[16];
#pragma unroll
            for (int i = 0; i < 16; i += 2) {
                typedef float f2 __attribute__((ext_vector_type(2)));
                const f2 xc = {XCF[(32 * tb + crow(i, hh)) * 128 + chl], XCF[(32 * tb + crow(i + 1, hh)) * 128 + chl]};
                const f2 ta = (f2){ya[i], ya[i + 1]} * -1.4426950408889634f, tx = (f2){yx[i], yx[i + 1]} * -1.4426950408889634f;
                f2 ea, ex; ea.x = __builtin_amdgcn_exp2f(ta.x); ea.y = __builtin_amdgcn_exp2f(ta.y); ex.x = __builtin_amdgcn_exp2f(tx.x); ex.y = __builtin_amdgcn_exp2f(tx.y);
                const f2 da = ea + 1.0f, dx = ex + 1.0f;
                f2 rg, ig; rg.x = __builtin_amdgcn_rcpf(da.x); rg.y = __builtin_amdgcn_rcpf(da.y); ig.x = __builtin_amdgcn_rcpf(dx.x); ig.y = __builtin_amdgcn_rcpf(dx.y);
                const f2 la = rg * sp8; f2 a; a.x = __builtin_amdgcn_exp2f(la.x); a.y = __builtin_amdgcn_exp2f(la.y);
                const f2 om = a * -a + 1.0f; f2 sq; sq.x = __builtin_amdgcn_sqrtf(om.x); sq.y = __builtin_amdgcn_sqrtf(om.y);
                const f2 b = sq * ig * xc;
                av[i] = a.x; av[i + 1] = a.y; bv[i] = b.x; bv[i + 1] = b.y; }
            float Ag[4], Bg[4], Ap[4], Bp[4];
#pragma unroll
            for (int g = 0; g < 4; ++g) { float A = 1.f, B = 0.f;
#pragma unroll
                for (int k = 0; k < 4; ++k) { const int kk = z ? 3 - k : k; B = B * av[4 * g + kk] + bv[4 * g + kk]; A *= av[4 * g + kk]; }
                Ag[g] = A; Bg[g] = B; Ap[g] = __shfl_xor(A, 32); Bp[g] = __shfl_xor(B, 32); }
            float ent[4]; float cur = st;
#pragma unroll
            for (int gi = 0; gi < 4; ++gi) { const int g = z ? 3 - gi : gi;
                const bool own_first = z ? (hh == 1) : (hh == 0);
                if (own_first) { ent[g] = cur; cur = Ag[g] * cur + Bg[g]; CB = Ag[g] * CB + Bg[g]; CA *= Ag[g]; cur = Ap[g] * cur + Bp[g]; CB = Ap[g] * CB + Bp[g]; CA *= Ap[g]; }
                else { cur = Ap[g] * cur + Bp[g]; CB = Ap[g] * CB + Bp[g]; CA *= Ap[g]; ent[g] = cur; cur = Ag[g] * cur + Bg[g]; CB = Ag[g] * CB + Bg[g]; CA *= Ag[g]; } }
            st = cur;
            if (FINAL) {
#pragma unroll
                for (int g = 0; g < 4; ++g) { float hc = ent[g];
#pragma unroll
                    for (int k = 0; k < 4; ++k) { const int kk = z ? 3 - k : k; hc = av[4 * g + kk] * hc + bv[4 * g + kk];
                        HS[(z * 64 + 32 * tb + 8 * g + 4 * hh + kk) * 128 + chl] = hc; } } }
        }
}
template <bool FINAL> __device__ __forceinline__ void rglru_pass(Frame& F) {
    const bf16* Z1 = WSP(const bf16, WS_Z); const bf16* WGT = WSP(const bf16, WS_WGT); bf16* AO = WSP(bf16, WS_AO);
    float* SUM = WSP(float, WS_SUM);
    const float* cw = F.in[20]; const float* cb = F.in[21];
    LAS unsigned char* XCB = F.lds;
    LAS float* XCF = (LAS float*)(F.lds + 17408);
    LAS float* HS = (LAS float*)(F.lds + 17408 + 32768);
    const int bx = blockIdx.x, h = bx & 15, cg = bx >> 4, ncg = F.G >> 4;
    if (cg >= ncg) return;
    const int r = F.lane & 31, hh = F.lane >> 5, jg = F.wave & 3, z = F.wave >> 2;
    const int chl = 32 * jg + r, ch = h * 128 + chl;
    bf16x8 wa[8], wx[8];
    { const bf16* pa = WGT + ((size_t)((z * 2 + 0) * 16 + h) * 128 + chl) * 128 + 8 * hh; const bf16* px = WGT + ((size_t)((z * 2 + 1) * 16 + h) * 128 + chl) * 128 + 8 * hh;
#pragma unroll
      for (int s = 0; s < 8; ++s) { wa[s] = *(const GAS bf16x8*)(pa + 16 * s); wx[s] = *(const GAS bf16x8*)(px + 16 * s); } }
    const float ba = F.in[23][z * DM + ch], bxx = F.in[25][z * DM + ch];
    const float sp8 = -8.0f * 1.4426950408889634f * log1pf(__expf(-F.in[26][z * DM + ch]));
    const int nch = FINAL ? 256 : NCHUNK;
    LAS float* CWL = (LAS float*)(F.lds + 17408 + 32768 + 65536);
    __syncthreads();
    for (int i = F.tid; i < 640; i += 512) CWL[i] = i < 512 ? cw[(i >> 7) * DM + h * 128 + (i & 127)] : cb[h * 128 + (i - 512)];
    __syncthreads();
    LAS float* CL = (LAS float*)(F.lds + 17408 + 32768 + 65536 + 2560);
    if (FINAL) { const int b = F.tid >> 8, zz = (F.tid >> 7) & 1, cl = F.tid & 127; const float* sb = SUM + ((size_t)zz * DM + h * 128 + cl) * 2;
        float s = 0.f;
#pragma unroll
        for (int i = 0; i < 4; ++i) { const int c = 256 + b * 4 + (zz ? 3 - i : i); const float2 ab = *(const float2*)(sb + (size_t)c * 4 * DM); s = ab.x * s + ab.y; }
#pragma unroll 8
        for (int i = 0; i < 128; ++i) { const int c = b * 128 + (zz ? 127 - i : i); const float2 ab = *(const float2*)(sb + (size_t)c * 4 * DM);
            const int d = c - cg; if (d >= 0 && d % ncg == 0) CL[(d / ncg) * 256 + zz * 128 + cl] = s;
            s = ab.x * s + ab.y; }
        __syncthreads(); }
    v4u xq[2][4];
#define RG_LOAD_ROWS(cc) do { const int _row0 = (cc) < 256 ? (cc) * 64 : ML + ((cc) - 256) * 64; \
        const int _s0 = (cc) < 256 ? ((cc) >> 7) * SEQ : ML + (((cc) - 256) >> 2) * CTXL, _s1 = _s0 + ((cc) < 256 ? SEQ : CTXL); \
        _Pragma("unroll") for (int it = 0; it < 2; ++it) { const int id = F.tid + 512 * it, row = _row0 + (id >> 4), gc = h * 128 + (id & 15) * 8; \
            _Pragma("unroll") for (int tap = 0; tap < 4; ++tap) { const int rr = row + tap - 2; v4u x = {0u, 0u, 0u, 0u}; \
                if (rr >= _s0 && rr < _s1) x = *(const GAS v4u*)(Z1 + (size_t)rr * 4096 + 2048 + gc); xq[it][tap] = x; } } } while (0)
    if (cg < nch) RG_LOAD_ROWS(cg);
    for (int c = cg; c < nch; c += ncg) {
        const int row0 = c < 256 ? c * 64 : ML + (c - 256) * 64;
        LDS_BARRIER();
#pragma unroll
        for (int it = 0; it < 2; ++it) { const int id = F.tid + 512 * it, t = id >> 4, c8 = (id & 15) * 8;
            float a[8];
            { const f32x4 b0 = *(const LAS f32x4*)(CWL + 512 + c8), b1 = *(const LAS f32x4*)(CWL + 512 + c8 + 4);
              a[0] = b0.x; a[1] = b0.y; a[2] = b0.z; a[3] = b0.w; a[4] = b1.x; a[5] = b1.y; a[6] = b1.z; a[7] = b1.w; }
#pragma unroll
            for (int tap = 0; tap < 4; ++tap) { const v4u x = xq[it][tap];
                const f32x4 w0 = *(const LAS f32x4*)(CWL + tap * 128 + c8), w1 = *(const LAS f32x4*)(CWL + tap * 128 + c8 + 4);
                a[0] += w0.x * bflo(x[0]); a[1] += w0.y * bfhi(x[0]); a[2] += w0.z * bflo(x[1]); a[3] += w0.w * bfhi(x[1]);
                a[4] += w1.x * bflo(x[2]); a[5] += w1.y * bfhi(x[2]); a[6] += w1.z * bflo(x[3]); a[7] += w1.w * bfhi(x[3]); }
            *(LAS f32x4*)(XCF + t * 128 + c8) = (f32x4){a[0], a[1], a[2], a[3]}; *(LAS f32x4*)(XCF + t * 128 + c8 + 4) = (f32x4){a[4], a[5], a[6], a[7]};
            v4u w; w.x = pk2(a[0], a[1]); w.y = pk2(a[2], a[3]); w.z = pk2(a[4], a[5]); w.w = pk2(a[6], a[7]);
            *(LAS v4u*)(XCB + t * 272 + c8 * 2) = w; }
        LDS_BARRIER();
        if (c + ncg < nch) RG_LOAD_ROWS(c + ncg);
        v4u gq[2];
        if (FINAL) {
#pragma unroll
            for (int it = 0; it < 2; ++it) { const int id = F.tid + 512 * it; gq[it] = *(const GAS v4u*)(Z1 + (size_t)(row0 + (id >> 4)) * 4096 + h * 128 + (id & 15) * 8); } }
        float st = 0.f, CA = 1.f, CB = 0.f;
        if (FINAL) st = CL[((c - cg) / ncg) * 256 + z * 128 + chl];
        if (z == 0) rglru_blocks<FINAL, 0>(XCB, XCF, HS, wa, wx, ba, bxx, sp8, r, hh, chl, st, CA, CB);
        else rglru_blocks<FINAL, 1>(XCB, XCF, HS, wa, wx, ba, bxx, sp8, r, hh, chl, st, CA, CB);
        if (!FINAL) { if (hh == 0) { float* sp = SUM + (((size_t)c * 2 + z) * DM + ch) * 2; sp[0] = CA; sp[1] = CB; } }
        else {
            LDS_BARRIER();
#pragma unroll
            for (int it = 0; it < 2; ++it) { const int id = F.tid + 512 * it, t = id >> 4, c8 = (id & 15) * 8, row = row0 + t, gc = h * 128 + c8;
                const f32x4 f0 = *(const LAS f32x4*)(HS + t * 128 + c8), f1 = *(const LAS f32x4*)(HS + t * 128 + c8 + 4);
                const f32x4 b0 = *(const LAS f32x4*)(HS + (64 + t) * 128 + c8), b1 = *(const LAS f32x4*)(HS + (64 + t) * 128 + c8 + 4);
                const v4u gt = gq[it];
                v4u w; w.x = pk2((f0.x + b0.x) * bflo(gt.x), (f0.y + b0.y) * bfhi(gt.x)); w.y = pk2((f0.z + b0.z) * bflo(gt.y), (f0.w + b0.w) * bfhi(gt.y));
                w.z = pk2((f1.x + b1.x) * bflo(gt.z), (f1.y + b1.y) * bfhi(gt.z)); w.w = pk2((f1.z + b1.z) * bflo(gt.w), (f1.w + b1.w) * bfhi(gt.w));
                *(GAS v4u*)(AO + (size_t)row * DM + gc) = w; }
        }
    }
#undef RG_LOAD_ROWS
}
__device__ __forceinline__ void route_phase(Frame& F) {
    const float* g = F.in[28]; const float* mod = WSP(const float, WS_MOD1); const float* rw = F.in[29]; const float* rb = F.in[30];
    bf16* XN = WSP(bf16, WS_XN);
    int* tok_e = WSP(int, WS_ROUTE); int* tok_rank = tok_e + 2 * ML; float* tok_w = (float*)(tok_rank + 2 * ML);
    LAS int* lcnt = (LAS int*)(F.lds); LAS int* lbase = lcnt + 8;
    LAS int* lrow = lcnt + 16;
    LAS f32x4* rwl = (LAS f32x4*)(F.lds + 2048);
    __syncthreads();
    for (int s4 = F.tid; s4 < 4096; s4 += 512) { const int k = s4 >> 1, half = s4 & 1, j = k >> 8, ln = (k >> 2) & 63, q = k & 3;
        rwl[((j * 4 + q) * 2 + half) * 64 + ln] = *(const GAS f32x4*)(rw + (size_t)k * 8 + 4 * half); }
    __syncthreads();
    for (int base = F.vcu * 64; base < ML; base += F.G * 64) {
        __syncthreads();
        if (F.tid < 8) lcnt[F.tid] = 0;
        __syncthreads();
        for (int i = 0; i < 8; ++i) { const int row = base + F.wave * 8 + i;
            const float* mv = mod + (size_t)(row >> 13) * MOD_W;
            const GAS v2u* xr = (const GAS v2u*)(WSP(const bf16, WS_H) + (size_t)row * DM) + F.lane;
            f32x4 v[8]; float s = 0.f;
#pragma unroll
            for (int j = 0; j < 8; ++j) { const v2u w = xr[64 * j]; v[j].x = bflo(w.x); v[j].y = bfhi(w.x); v[j].z = bflo(w.y); v[j].w = bfhi(w.y); s += (v[j].x * v[j].x + v[j].y * v[j].y) + (v[j].z * v[j].z + v[j].w * v[j].w); }
            const float rstd = 1.0f / sqrtf(wave_sum(s) * (1.0f / DM) + NORM_EPS);
            GAS unsigned* o4 = (GAS unsigned*)((unsigned char*)XN + (size_t)row * DM) + F.lane;
            float lg[8];
#pragma unroll
            for (int e = 0; e < 8; ++e) lg[e] = 0.f;
#pragma unroll
            for (int j = 0; j < 8; ++j) { const int col = 4 * (F.lane + 64 * j);
                const f32x4 gg = *(const GAS f32x4*)(g + col), sh = *(const GAS f32x4*)(mv + 3 * DM + col), sc = *(const GAS f32x4*)(mv + 4 * DM + col);
                const f32x4 y = v[j] * rstd * gg * (sc + 1.0f) + sh; o4[64 * j] = pk4_fp8(clamp8(y.x), clamp8(y.y), clamp8(y.z), clamp8(y.w));
#pragma unroll
                for (int q = 0; q < 4; ++q) { const f32x4 w0 = rwl[((j * 4 + q) * 2 + 0) * 64 + F.lane], w1 = rwl[((j * 4 + q) * 2 + 1) * 64 + F.lane];
                    lg[0] += y[q] * w0.x; lg[1] += y[q] * w0.y; lg[2] += y[q] * w0.z; lg[3] += y[q] * w0.w; lg[4] += y[q] * w1.x; lg[5] += y[q] * w1.y; lg[6] += y[q] * w1.z; lg[7] += y[q] * w1.w; } }
#pragma unroll
            for (int e = 0; e < 8; ++e) lg[e] = wave_sum(lg[e]) + rb[e];
            int e0 = 0; float l0 = lg[0];
#pragma unroll
            for (int e = 1; e < 8; ++e) if (lg[e] > l0) { l0 = lg[e]; e0 = e; }
            int e1 = -1; float l1 = -3.0e38f;
#pragma unroll
            for (int e = 0; e < 8; ++e) if (e != e0 && lg[e] > l1) { l1 = lg[e]; e1 = e; }
            if (F.lane == 0) { const float w1 = 1.0f / (1.0f + __expf(l0 - l1)); const int r0 = atomicAdd((int*)&lcnt[e0], 1), r1 = atomicAdd((int*)&lcnt[e1], 1);
                LAS int* pr = lrow + (F.wave * 8 + i) * 4; pr[0] = e0; pr[1] = r0; pr[2] = e1; pr[3] = r1;
                tok_e[2 * row] = e0; tok_e[2 * row + 1] = e1; tok_w[2 * row] = 1.0f - w1; tok_w[2 * row + 1] = w1; }
        }
        __syncthreads();
        if (F.tid < 8) lbase[F.tid] = (int)__hip_atomic_fetch_add((unsigned*)(F.ctl + CW_CNT + F.tid), (unsigned)lcnt[F.tid], RLX_AGENT);
        __syncthreads();
        if (F.tid < 64) { const int row = base + F.tid; const LAS int* pr = lrow + F.tid * 4; tok_rank[2 * row] = lbase[pr[0]] + pr[1]; tok_rank[2 * row + 1] = lbase[pr[2]] + pr[3]; }
        VM_WAIT();
        { unsigned char* XGS = F.ws + WS_XGS;
#pragma unroll
          for (int i = 0; i < 8; ++i) { const int row = base + F.wave * 8 + i; const LAS int* pr = lrow + (F.wave * 8 + i) * 4;
              const v4u* src = (const v4u*)((const unsigned char*)XN + (size_t)row * DM) + F.lane;
              const v4u x0 = __builtin_nontemporal_load((const GAS v4u*)src), x1 = __builtin_nontemporal_load((const GAS v4u*)(src + 64));
#pragma unroll
              for (int sl = 0; sl < 2; ++sl) { const int e = pr[2 * sl], rk = lbase[e] + pr[2 * sl + 1];
                  GAS v4u* dst = (GAS v4u*)(XGS + ((size_t)e * ML + rk) * DM) + F.lane; dst[0] = x0; dst[64] = x1; } } }
    }
}
__device__ __forceinline__ void gather_phase(Frame& F) {
    const bf16* XN = WSP(const bf16, WS_XN); bf16* XG = WSP(bf16, WS_Z);
    const int* tok_e = WSP(const int, WS_ROUTE); const int* tok_rank = tok_e + 2 * ML;
    int off[8]; { int t = 0;
#pragma unroll
        for (int e = 0; e < 8; ++e) { off[e] = t; t += ((__builtin_amdgcn_readfirstlane((int)F.ctl[CW_CNT + e]) + 255) >> 8) << 8; } }
    const int gw = F.vcu * NWAVES + F.wave, NGW = F.G * NWAVES;
    for (int a = gw; a < 2 * ML; a += NGW) { const int row = a >> 1, e = tok_e[a], rk = tok_rank[a]; int o = 0;
#pragma unroll
        for (int k = 0; k < 8; ++k) o = (e == k) ? off[k] : o;
        const GAS v4u* src = (const GAS v4u*)((const unsigned char*)XN + (size_t)row * DM) + F.lane; GAS v4u* dst = (GAS v4u*)((unsigned char*)XG + (size_t)(o + rk) * DM) + F.lane;
#pragma unroll
        for (int j = 0; j < 2; ++j) dst[64 * j] = src[64 * j]; }
}
__device__ __forceinline__ f32x4 y2_load(Frame& F, const bf16* Y2, size_t s, int col) {
    f32x4 r;
    if (s < (size_t)Y2_FULL_TILES * 256 * DM) { const v2u y = *(const GAS v2u*)(Y2 + s + col); r.x = bflo(y.x); r.y = bfhi(y.x); r.z = bflo(y.y); r.w = bfhi(y.y); }
    else { const bf16* P = WSP(const bf16, WS_XN) + (s - (size_t)Y2_FULL_TILES * 256 * DM) + col; r = (f32x4){0.f, 0.f, 0.f, 0.f};
#pragma unroll
        for (int p = 0; p < 7; ++p) { const v2u y = *(const GAS v2u*)(P + (size_t)p * Y2_PART_ROWS * DM); r.x += bflo(y.x); r.y += bfhi(y.x); r.z += bflo(y.y); r.w += bfhi(y.y); } }
    return r;
}
__device__ __forceinline__ void final_phase(Frame& F) {
    const bf16* Y2 = WSP(const bf16, WS_Z); const float* mod = WSP(const float, WS_MOD1); const float* fg = F.in[34];
    const int* tok_e = WSP(const int, WS_ROUTE); const int* tok_rank = tok_e + 2 * ML; const float* tok_w = (const float*)(tok_rank + 2 * ML);
    int off[8]; { int t = 0;
#pragma unroll
        for (int e = 0; e < 8; ++e) { off[e] = t; t += ((__builtin_amdgcn_readfirstlane((int)F.ctl[CW_CNT + e]) + 255) >> 8) << 8; } }
    const int gw = F.vcu * NWAVES + F.wave, NGW = F.G * NWAVES;
    for (int row = gw; row < ML; row += NGW) {
        const int e0 = tok_e[2 * row], e1 = tok_e[2 * row + 1]; int o0 = 0, o1 = 0;
#pragma unroll
        for (int k = 0; k < 8; ++k) { o0 = (e0 == k) ? off[k] : o0; o1 = (e1 == k) ? off[k] : o1; }
        const size_t s0 = (size_t)(o0 + tok_rank[2 * row]) * DM, s1 = (size_t)(o1 + tok_rank[2 * row + 1]) * DM; const float w0 = tok_w[2 * row], w1 = tok_w[2 * row + 1];
        const float* g2 = mod + (size_t)(row >> 13) * MOD_W + 5 * DM;
        GAS f32x4* xr = (GAS f32x4*)(F.out + (size_t)row * DM) + F.lane;
        const GAS v2u* hr = (const GAS v2u*)(WSP(const bf16, WS_H) + (size_t)row * DM) + F.lane;
        f32x4 v[8]; float s = 0.f;
        const bool tail = __builtin_amdgcn_readfirstlane((int)((s0 >= (size_t)Y2_FULL_TILES * 256 * DM) | (s1 >= (size_t)Y2_FULL_TILES * 256 * DM))) != 0;
        if (!tail) {
#pragma unroll
            for (int j = 0; j < 8; ++j) { const int col = 4 * (F.lane + 64 * j);
                const v2u ya = *(const GAS v2u*)(Y2 + s0 + col), yb = *(const GAS v2u*)(Y2 + s1 + col); const f32x4 gg = *(const GAS f32x4*)(g2 + col);
                f32x4 mo; mo.x = w0 * bflo(ya.x) + w1 * bflo(yb.x); mo.y = w0 * bfhi(ya.x) + w1 * bfhi(yb.x); mo.z = w0 * bflo(ya.y) + w1 * bflo(yb.y); mo.w = w0 * bfhi(ya.y) + w1 * bfhi(yb.y);
                { const v2u hw = hr[64 * j]; f32x4 hv; hv.x = bflo(hw.x); hv.y = bfhi(hw.x); hv.z = bflo(hw.y); hv.w = bfhi(hw.y); v[j] = hv + gg * mo; } s += (v[j].x * v[j].x + v[j].y * v[j].y) + (v[j].z * v[j].z + v[j].w * v[j].w); }
        } else {
#pragma unroll
            for (int j = 0; j < 8; ++j) { const int col = 4 * (F.lane + 64 * j);
                const f32x4 fa = y2_load(F, Y2, s0, col), fb = y2_load(F, Y2, s1, col); const f32x4 gg = *(const GAS f32x4*)(g2 + col);
                const f32x4 mo = w0 * fa + w1 * fb;
                { const v2u hw = hr[64 * j]; f32x4 hv; hv.x = bflo(hw.x); hv.y = bfhi(hw.x); hv.z = bflo(hw.y); hv.w = bfhi(hw.y); v[j] = hv + gg * mo; } s += (v[j].x * v[j].x + v[j].y * v[j].y) + (v[j].z * v[j].z + v[j].w * v[j].w); }
        }
        const float rstd = 1.0f / sqrtf(wave_sum(s) * (1.0f / DM) + NORM_EPS);
#pragma unroll
        for (int j = 0; j < 8; ++j) { const int col = 4 * (F.lane + 64 * j); xr[64 * j] = v[j] * rstd * *(const GAS f32x4*)(fg + col); }
    }
}
constexpr int N_PHASES = 20;
#ifndef MK_ONE_LAUNCH
#define MK_ONE_LAUNCH 1
#endif
__global__ void __launch_bounds__(NWAVES * 64, 2) fwd_kernel(Args args) {
    extern __shared__ __attribute__((aligned(16))) unsigned char lds_raw[];
    Frame F;
    F.lds = (LAS unsigned char*)lds_raw;
    F.tid = threadIdx.x; F.lane = F.tid & 63; F.wave = __builtin_amdgcn_readfirstlane(F.tid >> 6);
    F.G = gridDim.x; { const int bx = blockIdx.x; F.vcu = (F.G % 8 == 0) ? (bx % 8) * (F.G / 8) + bx / 8 : bx; }
    F.in = args.in; F.out = args.out; F.ws = args.ws; F.ctl = (gu32*)(args.ws + WS_CTL);
    volatile LAS unsigned* MISC = (volatile LAS unsigned*)(F.lds + MISC_OFF);
    for (int u = F.tid; u < (LDS_BYTES - MISC_OFF) / 4; u += NWAVES * 64) MISC[u] = 0u;
    __syncthreads();
    const int lo = args.ph_lo, hi = args.ph_hi;
    XcdBarrier bar = xcd_barrier_post((unsigned*)(F.ctl + CW_BAR), MISC + 8, (unsigned)gridDim.x);
#ifdef ONLY_PH
#define IN(k) ((k) == ONLY_PH)
#else
#define IN(k) (lo <= (k) && (k) < hi)
#endif
#ifndef MK_NCV7
#define MK_NCV7 56
#endif
#ifndef MK_NCV8
#define MK_NCV8 80
#endif
#ifndef MK_TAIL_MASK
#define MK_TAIL_MASK ((1u << 7) | (1u << 8))
#endif
#define SEAM(k) do { if (IN(k) && IN((k) + 1)) { if ((MK_TAIL_MASK >> (k)) & 1u) moe_pull(F, (k), 0); if ((k) == 9) moe_pull(F, -1, NQ_LATE); if ((k) == 15) moe_pull(F, -1, NQ); xcd_barrier(bar); { int t_ = threadIdx.x; asm volatile("" : "+v"(t_)); F.tid = t_; F.lane = t_ & 63; } } } while (0)
    const pg8::bf16_t* XN = WSP(const pg8::bf16_t, WS_XN);

    if (IN(0)) { p0_prologue(F); } SEAM(0);
    if (IN(1)) { norm_phase<false>(F, F.in[0], F.in[2], F.in[6], WSP(const float, WS_MOD0), 0, DM, MT); } SEAM(1);
    if (IN(2)) { pg8::Gemm g{XN, WSP(const pg8::bf16_t, WS_WIN0), MT, EIN, DM, 0, DM, 0, 0}; pg8::StaticOrder S; S.init(MT, EIN, F.G, (int)blockIdx.x);
        pg8::EpiBf16 E{WSP(pg8::bf16_t, WS_Z), EIN, 0, 0, 1.0f};
        pg8::gemm_phase<pg8::EpiBf16, pg8::StaticOrder, true, true>(F.lds, g, S, E); } SEAM(2);
    if (IN(3)) { rope_conv_phase(F); } SEAM(3);
    if (IN(4)) { attn_phase(F); } SEAM(4);
    if (IN(5)) { pg8::Gemm g{WSP(const pg8::bf16_t, WS_AO), WSP(const pg8::bf16_t, WS_WOUT0), MT, DM, DM, 0, DM, 0, 0}; pg8::StaticOrder S; S.init(MT, DM, F.G, (int)blockIdx.x);
        pg8::EpiResH<false> E{F.in[0], F.in[2], WSP(pg8::bf16_t, WS_H), WSP(const float, WS_MOD0) + 2 * DM, 1.0f};
        pg8::gemm_phase<pg8::EpiResH<false>, pg8::StaticOrder, true, true>(F.lds, g, S, E); } SEAM(5);
    if (IN(6)) { norm_phase<FFN8 != 0, true>(F, nullptr, nullptr, F.in[12], WSP(const float, WS_MOD0), 3 * DM, 4 * DM, MT); } SEAM(6);
    const int GWK7 = F.G >= 2 * MK_NCV7 ? F.G - MK_NCV7 : F.G, GWK8 = F.G >= 2 * MK_NCV8 ? F.G - MK_NCV8 : F.G;
    if (IN(7) && (int)blockIdx.x < GWK7) { pg8::Gemm g{XN, WSP(const pg8::bf16_t, WS_WGU0), MT, 2 * DFF, FFN8 ? DM / 2 : DM, 0, FFN8 ? DM / 2 : DM, 0, 0}; pg8::StaticOrder S; S.init(MT, 2 * DFF, GWK7, (int)blockIdx.x);
        if constexpr (FFN8) { pg8::EpiSwiGLU8 E{WSP(unsigned char, WS_HID), DFF, 4.0f, 1.0f / 64.0f}; pg8::gemm_phase<pg8::EpiSwiGLU8, pg8::StaticOrder, true, true, true>(F.lds, g, S, E); }
        else { pg8::EpiSwiGLU E{WSP(pg8::bf16_t, WS_HID), DFF}; pg8::gemm_phase<pg8::EpiSwiGLU, pg8::StaticOrder, true, true>(F.lds, g, S, E); } } SEAM(7);
    if (IN(8) && (int)blockIdx.x < GWK8) { pg8::Gemm g{WSP(const pg8::bf16_t, WS_HID), WSP(const pg8::bf16_t, WS_WD0), MT, DM, FFN8 ? DFF / 2 : DFF, 0, FFN8 ? DFF / 2 : DFF, 0, 0}; pg8::StaticOrder S; S.init(MT, DM, GWK8, (int)blockIdx.x);
        pg8::EpiResH<true> E{nullptr, nullptr, WSP(pg8::bf16_t, WS_H), WSP(const float, WS_MOD0) + 5 * DM, FFN8 ? 1.0f / 256.0f : 1.0f};
        pg8::gemm_phase<pg8::EpiResH<true>, pg8::StaticOrder, true, true, FFN8 != 0>(F.lds, g, S, E); } SEAM(8);
    if (IN(9)) { norm_phase<false, true>(F, nullptr, nullptr, F.in[18], WSP(const float, WS_MOD1), 0, DM, MT); } SEAM(9);
    if (IN(10)) { pg8::Gemm g{XN, WSP(const pg8::bf16_t, WS_WIN1), MT, 2 * DM, DM, 0, DM, 0, 0}; pg8::StaticOrder S; S.init(MT, 2 * DM, F.G, (int)blockIdx.x);
        pg8::EpiBf16 E{WSP(pg8::bf16_t, WS_Z), 2 * DM, 8, 0, 1.0f};
        pg8::gemm_phase<pg8::EpiBf16, pg8::StaticOrder, true, true>(F.lds, g, S, E); } SEAM(10);
    if (IN(11)) { rglru_pass<false>(F); } SEAM(11);
    if (IN(13)) { rglru_pass<true>(F); } SEAM(13);
    if (IN(14)) { pg8::Gemm g{WSP(const pg8::bf16_t, WS_AO), WSP(const pg8::bf16_t, WS_WOUT1), ML, DM, DM, 0, DM, 0, 0}; pg8::StaticOrder S; S.init(ML, DM, F.G, (int)blockIdx.x);
        pg8::EpiResH<true> E{nullptr, nullptr, WSP(pg8::bf16_t, WS_H), WSP(const float, WS_MOD1) + 2 * DM, 1.0f};
        pg8::gemm_phase<pg8::EpiResH<true>, pg8::StaticOrder, true, true>(F.lds, g, S, E); } SEAM(14);
    if (IN(15)) { route_phase(F); } SEAM(15);
    if (IN(17)) { pg8::Gemm g{WSP(const pg8::bf16_t, WS_XGS), WSP(const pg8::bf16_t, WS_MWGU), CAP, 2 * DFFE, DM / 2, (size_t)2 * DFFE * DM, DM / 2, 0x79797979, 0x7F7F7F7F}; pg8::MoeOrder S; S.init((const int*)(F.ctl + CW_CNT), 2 * DFFE, 1, F.G, (int)blockIdx.x); S.atile = ML / 256;
        pg8::EpiSwiGLU8 E{WSP(unsigned char, WS_HID), DFFE, 4.0f, 1.0f / 64.0f};
        pg8::gemm_phase<pg8::EpiSwiGLU8, pg8::MoeOrder, true, false, true>(F.lds, g, S, E); } SEAM(17);
    if (IN(18)) { pg8::Gemm g{WSP(const pg8::bf16_t, WS_HID), WSP(const pg8::bf16_t, WS_MWD), CAP, DM, DFFE / 2, (size_t)DM * DFFE, DFFE / 2, 0x79797979, 0x7D7D7D7D}; pg8::MoeOrder S; S.init((const int*)(F.ctl + CW_CNT), DM, 1, F.G, (int)blockIdx.x, 0, Y2_FULL_TILES);
        pg8::EpiBf16 E{WSP(pg8::bf16_t, WS_Z), DM, 0, 0, 1.0f / (64.0f * 4.0f)};
        pg8::gemm_phase<pg8::EpiBf16, pg8::MoeOrder, true, true, true>(F.lds, g, S, E);
        pg8::Gemm g2{WSP(const pg8::bf16_t, WS_HID), WSP(const pg8::bf16_t, WS_MWD), CAP, DM, DFFE / 2, (size_t)DM * DFFE, DFFE / 14, 0x79797979, 0x7D7D7D7D}; pg8::MoeOrder S2; S2.init((const int*)(F.ctl + CW_CNT), DM, 7, F.G, (int)blockIdx.x, Y2_FULL_TILES);
        pg8::EpiBf16 E2{WSP(pg8::bf16_t, WS_XN) - (size_t)Y2_FULL_TILES * 256 * DM, DM, 0, (size_t)Y2_PART_ROWS * DM, 1.0f / (64.0f * 4.0f)};
        pg8::gemm_phase<pg8::EpiBf16, pg8::MoeOrder, true, true, true>(F.lds, g2, S2, E2); } SEAM(18);
    if (IN(19)) { final_phase(F); }
#undef IN
#undef SEAM
#undef SEAM_A
}

extern "C" void kernel_launch(void* const* d_in, const int* in_sizes, int n_in, void* d_out, int out_size, void* d_ws, size_t ws_size, hipStream_t stream) {
    static int grid = 0;
    if (grid == 0) {
        if (n_in != 35 || out_size != ML * DM || ws_size < WS_END) { fprintf(stderr, "kernel_launch: unexpected shapes (n_in %d out %d ws %zu need %zu)\n", n_in, out_size, ws_size, (size_t)WS_END); grid = -1; return; }
        int dev = 0, cus = 0, per_cu = 0;
        if (hipGetDevice(&dev) != hipSuccess || hipDeviceGetAttribute(&cus, hipDeviceAttributeMultiprocessorCount, dev) != hipSuccess) { grid = -1; return; }
        if (hipFuncSetAttribute((const void*)fwd_kernel, hipFuncAttributeMaxDynamicSharedMemorySize, LDS_BYTES) != hipSuccess) { fprintf(stderr, "kernel_launch: hipFuncSetAttribute failed\n"); grid = -1; return; }
        if (hipOccupancyMaxActiveBlocksPerMultiprocessor(&per_cu, (const void*)fwd_kernel, NWAVES * 64, LDS_BYTES) != hipSuccess || per_cu < 1) { fprintf(stderr, "kernel_launch: occupancy query says %d\n", per_cu); }
        (void)hipGetLastError();
        grid = cus;
    }
    if (grid < 0) return;
    (void)hipMemsetAsync((char*)d_ws + WS_CTL, 0, CTL_ZERO_BYTES, stream);
    Args a{};
    for (int i = 0; i < 35; ++i) a.in[i] = (const float*)d_in[i];
    a.out = (float*)d_out; a.ws = (unsigned char*)d_ws;
#if MK_ONE_LAUNCH
    a.ph_lo = 0; a.ph_hi = N_PHASES;
    hipLaunchKernelGGL(fwd_kernel, dim3(grid), dim3(NWAVES * 64), LDS_BYTES, stream, a);
#else
    for (int p = 0; p < N_PHASES; ++p) { a.ph_lo = p; a.ph_hi = p + 1;
        hipLaunchKernelGGL(fwd_kernel, dim3(grid), dim3(NWAVES * 64), LDS_BYTES, stream, a); }
#endif
}
```

```cpp
#include <hip/hip_runtime.h>
#include <cstdio>
#include <cstdint>
namespace pg8 {
#define PG8_LAS __attribute__((address_space(3)))
typedef unsigned short bf16_t;
typedef short bf16x8 __attribute__((ext_vector_type(8)));
typedef float f32x4 __attribute__((ext_vector_type(4)));
typedef unsigned u32x4 __attribute__((ext_vector_type(4)));
typedef int i32x4 __attribute__((ext_vector_type(4)));
typedef int i32x8 __attribute__((ext_vector_type(8)));
constexpr int BM = 256, BK = 64, HALF = 128, HTB = HALF * BK * 2  , STAGE_BYTES = 8 * HTB, NXCD = 8, WGM = 8;

__host__ __device__ __forceinline__ int lds_byte(int r, int c) { const int st = (r >> 4) * 2 + (c >> 5), rr = r & 15, cc = c & 31, ob = rr * 64 + cc * 2; return st * 1024 + (ob ^ (((ob >> 9) & 1) << 5)); }
__host__ __device__ __forceinline__ void stage_rc(int b, int& R, int& C) { const int st = b / 1024, sb = b % 1024, swz = sb ^ (((sb >> 9) & 1) << 5); R = (st >> 1) * 16 + swz / 64; C = (st & 1) * 32 + (swz % 64) / 2; }
__host__ __device__ __forceinline__ int perm32(int rho) { const int n = rho >> 4, i = rho & 15; return 8 * (i >> 2) + 4 * n + (i & 3); }

struct Unit { int pm, pn, be, ks, pa; };
struct Gemm { const bf16_t* A; const bf16_t* Bt; int M, N, K; size_t bstride; int KL; int sw, sa; };

struct StaticOrder {
    int nM, nN, nwg, G, c;
    __host__ __device__ void init(int M, int N, int G_, int c_) { nM = M / BM; nN = N / BM; nwg = nM * nN; G = G_; c = c_; }
    __host__ __device__ bool next(int i, Unit& u) const {
        const long L = (long)i * G + c; if (L >= nwg) return false;
        int wgid = (int)L; { const int q = nwg / NXCD, r = nwg % NXCD, xcd = wgid % NXCD, off = wgid / NXCD; wgid = (xcd < r ? xcd * (q + 1) : r * (q + 1) + (xcd - r) * q) + off; }
        const int nig = WGM * nN, gid = wgid / nig, fm = gid * WGM, gsz = (nM - fm) < WGM ? (nM - fm) : WGM;
        u.pm = fm + ((wgid % nig) % gsz); u.pn = (wgid % nig) / gsz; u.be = 0; u.ks = 0; u.pa = u.pm; return true;
    }
    __device__ __forceinline__ void a_ready(const Unit&) const {}
    __device__ __forceinline__ void done(const Unit&) const {}
};

__device__ __forceinline__ unsigned cvt_pk_bf16(float lo, float hi) { unsigned r; asm volatile("v_cvt_pk_bf16_f32 %0, %1, %2" : "=v"(r) : "v"(lo), "v"(hi)); return r; }
__device__ __forceinline__ float fast_sigmoid(float x) { return __builtin_amdgcn_rcpf(1.0f + __builtin_amdgcn_exp2f(-1.4426950408889634f * x)); }
__device__ __forceinline__ float gelu_tanh(float x) { const float y = x + 0.044715f * x * x * x; return x * __builtin_amdgcn_rcpf(1.0f + __builtin_amdgcn_exp2f(-2.302208198f * y)); }

struct EpiBf16 {
    static constexpr bool PERM = true, AFTER_DRAIN = false;
    bf16_t* O; int ldc; int nact; size_t ks_stride; float ascale;
    __device__ __forceinline__ void operator()(const f32x4 (&acc)[2][2][4][2], const Unit& u, int wr, int wc, int fr, int fq) const {
        const int row0 = u.pm * BM + wr * 64 + fr, col0 = u.pn * BM + wc * 32 + 8 * fq; const bool act = u.pn < nact;
#pragma unroll
        for (int ai = 0; ai < 2; ++ai)
#pragma unroll
            for (int m = 0; m < 4; ++m) { bf16_t* rowp = O + (size_t)u.ks * ks_stride + (size_t)(row0 + ai * HALF + m * 16) * ldc + col0;
#pragma unroll
                for (int bj = 0; bj < 2; ++bj) { f32x4 v0 = acc[ai][bj][m][0] * ascale, v1 = acc[ai][bj][m][1] * ascale;
                    if (act) {
#pragma unroll
                        for (int j = 0; j < 4; ++j) { v0[j] = gelu_tanh(v0[j]); v1[j] = gelu_tanh(v1[j]); } }
                    u32x4 w; w.x = cvt_pk_bf16(v0[0], v0[1]); w.y = cvt_pk_bf16(v0[2], v0[3]); w.z = cvt_pk_bf16(v1[0], v1[1]); w.w = cvt_pk_bf16(v1[2], v1[3]);
                    *(u32x4*)(rowp + bj * HALF) = w; } }
    }
};
struct EpiSwiGLU {
    static constexpr bool PERM = true, AFTER_DRAIN = false;
    bf16_t* O; int ldc;
    __device__ __forceinline__ void operator()(const f32x4 (&acc)[2][2][4][2], const Unit& u, int wr, int wc, int fr, int fq) const {
        const int row0 = u.pm * BM + wr * 64 + fr, col0 = u.pn * HALF + wc * 32 + 8 * fq;
#pragma unroll
        for (int ai = 0; ai < 2; ++ai)
#pragma unroll
            for (int m = 0; m < 4; ++m) { bf16_t* rowp = O + (size_t)(row0 + ai * HALF + m * 16) * ldc + col0;
                f32x4 h0, h1;
#pragma unroll
                for (int j = 0; j < 4; ++j) { const float g0 = acc[ai][0][m][0][j], g1 = acc[ai][0][m][1][j];
                    h0[j] = g0 * fast_sigmoid(g0) * acc[ai][1][m][0][j]; h1[j] = g1 * fast_sigmoid(g1) * acc[ai][1][m][1][j]; }
                u32x4 w; w.x = cvt_pk_bf16(h0[0], h0[1]); w.y = cvt_pk_bf16(h0[2], h0[3]); w.z = cvt_pk_bf16(h1[0], h1[1]); w.w = cvt_pk_bf16(h1[2], h1[3]);
                *(u32x4*)rowp = w; }
    }
};
struct EpiSwiGLU8 {
    static constexpr bool PERM = true, AFTER_DRAIN = false;
    unsigned char* O; int ldc; float scale, ascale;
    typedef float f2 __attribute__((ext_vector_type(2)));
    __device__ __forceinline__ f2 swi2(f2 G, f2 U, float kexp, float kout) const {
        const f2 t = G * kexp; f2 e; e.x = __builtin_amdgcn_exp2f(t.x); e.y = __builtin_amdgcn_exp2f(t.y);
        const f2 d = e + 1.0f; f2 r; r.x = __builtin_amdgcn_rcpf(d.x); r.y = __builtin_amdgcn_rcpf(d.y);
        f2 h = (G * U) * r * kout; h.x = __builtin_amdgcn_fmed3f(h.x, -448.f, 448.f); h.y = __builtin_amdgcn_fmed3f(h.y, -448.f, 448.f); return h; }
    __device__ __forceinline__ void operator()(const f32x4 (&acc)[2][2][4][2], const Unit& u, int wr, int wc, int fr, int fq) const {
        const int row0 = u.pm * BM + wr * 64 + fr, col0 = u.pn * HALF + wc * 32 + 8 * fq;
        const float kexp = -1.4426950408889634f * ascale, kout = ascale * ascale * scale;
#pragma unroll
        for (int ai = 0; ai < 2; ++ai)
#pragma unroll
            for (int m = 0; m < 4; ++m) { unsigned char* rowp = O + (size_t)(row0 + ai * HALF + m * 16) * ldc + col0;
                const f32x4 g0 = acc[ai][0][m][0], g1 = acc[ai][0][m][1], u0 = acc[ai][1][m][0], u1 = acc[ai][1][m][1];
                const f2 a = swi2((f2){g0[0], g0[1]}, (f2){u0[0], u0[1]}, kexp, kout), b = swi2((f2){g0[2], g0[3]}, (f2){u0[2], u0[3]}, kexp, kout);
                const f2 c = swi2((f2){g1[0], g1[1]}, (f2){u1[0], u1[1]}, kexp, kout), d = swi2((f2){g1[2], g1[3]}, (f2){u1[2], u1[3]}, kexp, kout);
                int p0 = 0, p1 = 0;
                p0 = __builtin_amdgcn_cvt_pk_fp8_f32(a.x, a.y, p0, false); p0 = __builtin_amdgcn_cvt_pk_fp8_f32(b.x, b.y, p0, true);
                p1 = __builtin_amdgcn_cvt_pk_fp8_f32(c.x, c.y, p1, false); p1 = __builtin_amdgcn_cvt_pk_fp8_f32(d.x, d.y, p1, true);
                typedef unsigned u32x2 __attribute__((ext_vector_type(2))); u32x2 w; w.x = (unsigned)p0; w.y = (unsigned)p1; *(u32x2*)rowp = w; }
    }
};
struct EpiRes {
    static constexpr bool PERM = false, AFTER_DRAIN = false;
    const float* resL; const float* resC; float* outL; float* outC; const float* gate; int ldc; float ascale;
    __device__ __forceinline__ void operator()(const f32x4 (&acc)[2][2][4][2], const Unit& u, int wr, int wc, int fr, int fq) const {
        const bool isc = u.pm >= 64; const int pml = isc ? u.pm - 64 : u.pm; const int v = isc ? 2 : (u.pm >> 5);
        const float* res = isc ? resC : resL; float* out = isc ? outC : outL; const float* gv = gate + (size_t)v * 12288;
        const int row0 = pml * BM + wr * 64 + fr, col0 = u.pn * BM + wc * 32 + 4 * fq;
        f32x4 gg[2][2];
#pragma unroll
        for (int bj = 0; bj < 2; ++bj)
#pragma unroll
            for (int n = 0; n < 2; ++n) gg[bj][n] = *(const f32x4*)(gv + col0 + bj * HALF + n * 16) * ascale;
#pragma unroll
        for (int ai = 0; ai < 2; ++ai) {
            f32x4 bs[4][2][2];
#pragma unroll
            for (int m = 0; m < 4; ++m) { const size_t off = (size_t)(row0 + ai * HALF + m * 16) * ldc + col0;
#pragma unroll
                for (int bj = 0; bj < 2; ++bj)
#pragma unroll
                    for (int n = 0; n < 2; ++n) bs[m][bj][n] = *(const f32x4*)(res + off + bj * HALF + n * 16); }
#pragma unroll
            for (int m = 0; m < 4; ++m) { const size_t off = (size_t)(row0 + ai * HALF + m * 16) * ldc + col0;
#pragma unroll
                for (int bj = 0; bj < 2; ++bj)
#pragma unroll
                    for (int n = 0; n < 2; ++n) *(f32x4*)(out + off + bj * HALF + n * 16) = bs[m][bj][n] + gg[bj][n] * acc[ai][bj][m][n]; }
            asm volatile("" ::: "memory"); }
    }
};
template <bool RB> struct EpiResH {
    static constexpr bool PERM = true, AFTER_DRAIN = false;
    const float* resL; const float* resC; bf16_t* H; const float* gate; float ascale;
    __device__ __forceinline__ void operator()(const f32x4 (&acc)[2][2][4][2], const Unit& u, int wr, int wc, int fr, int fq) const {
        const bool isc = u.pm >= 64; const int v = isc ? 2 : (u.pm >> 5);
        const float* gv = gate + (size_t)v * 12288;
        const int row0 = u.pm * BM + wr * 64 + fr, col0 = u.pn * BM + wc * 32 + 8 * fq;
        f32x4 gg[2][2];
#pragma unroll
        for (int bj = 0; bj < 2; ++bj)
#pragma unroll
            for (int n = 0; n < 2; ++n) gg[bj][n] = *(const f32x4*)(gv + col0 + bj * HALF + n * 4) * ascale;
#pragma unroll
        for (int ai = 0; ai < 2; ++ai) {
            if constexpr (RB) {
                u32x4 bs[4][2];
#pragma unroll
                for (int m = 0; m < 4; ++m)
#pragma unroll
                    for (int bj = 0; bj < 2; ++bj) bs[m][bj] = *(const u32x4*)(H + (size_t)(row0 + ai * HALF + m * 16) * 2048 + col0 + bj * HALF);
#pragma unroll
                for (int m = 0; m < 4; ++m)
#pragma unroll
                    for (int bj = 0; bj < 2; ++bj) { const u32x4 b = bs[m][bj];
                        f32x4 r0, r1; r0.x = __builtin_bit_cast(float, b.x << 16); r0.y = __builtin_bit_cast(float, b.x & 0xffff0000u); r0.z = __builtin_bit_cast(float, b.y << 16); r0.w = __builtin_bit_cast(float, b.y & 0xffff0000u);
                        r1.x = __builtin_bit_cast(float, b.z << 16); r1.y = __builtin_bit_cast(float, b.z & 0xffff0000u); r1.z = __builtin_bit_cast(float, b.w << 16); r1.w = __builtin_bit_cast(float, b.w & 0xffff0000u);
                        r0 += gg[bj][0] * acc[ai][bj][m][0]; r1 += gg[bj][1] * acc[ai][bj][m][1];
                        u32x4 w; w.x = cvt_pk_bf16(r0[0], r0[1]); w.y = cvt_pk_bf16(r0[2], r0[3]); w.z = cvt_pk_bf16(r1[0], r1[1]); w.w = cvt_pk_bf16(r1[2], r1[3]);
                        *(u32x4*)(H + (size_t)(row0 + ai * HALF + m * 16) * 2048 + col0 + bj * HALF) = w; }
            } else {
                const float* res = isc ? resC - (size_t)16384 * 2048 : resL;
                f32x4 bs[4][2][2];
#pragma unroll
                for (int m = 0; m < 4; ++m)
#pragma unroll
                    for (int bj = 0; bj < 2; ++bj)
#pragma unroll
                        for (int n = 0; n < 2; ++n) bs[m][bj][n] = *(const f32x4*)(res + (size_t)(row0 + ai * HALF + m * 16) * 2048 + col0 + bj * HALF + n * 4);
#pragma unroll
                for (int m = 0; m < 4; ++m)
#pragma unroll
                    for (int bj = 0; bj < 2; ++bj) { const f32x4 r0 = bs[m][bj][0] + gg[bj][0] * acc[ai][bj][m][0], r1 = bs[m][bj][1] + gg[bj][1] * acc[ai][bj][m][1];
                        u32x4 w; w.x = cvt_pk_bf16(r0[0], r0[1]); w.y = cvt_pk_bf16(r0[2], r0[3]); w.z = cvt_pk_bf16(r1[0], r1[1]); w.w = cvt_pk_bf16(r1[2], r1[3]);
                        *(u32x4*)(H + (size_t)(row0 + ai * HALF + m * 16) * 2048 + col0 + bj * HALF) = w; }
            }
            asm volatile("" ::: "memory"); }
    }
};
struct MoeOrder {
    int nM, nN, nwg, G, c, nNr, pm0, atile; int toff[9];
    __device__ __forceinline__ void init(const int* counts, int N, int nsplit, int G_, int c_, int pm_lo = 0, int pm_hi = 1 << 20) { int t = 0;
#pragma unroll
        for (int e = 0; e < 8; ++e) { toff[e] = t; t += (__builtin_amdgcn_readfirstlane(counts[e]) + 255) >> 8; }
        toff[8] = t; atile = 0; const int hi = t < pm_hi ? t : pm_hi; pm0 = pm_lo; nM = hi > pm_lo ? hi - pm_lo : 0; nNr = N / BM; nN = nNr * nsplit; nwg = nM * nN; G = G_; c = c_; }
    __device__ __forceinline__ bool next(int i, Unit& u) const {
        const long L = (long)i * G + c; if (L >= nwg) return false;
        int pml, v;
        if ((nN & 7) == 0) {
            const int FULL = 32 * nN, nfull = nM >> 5, remm = nM & 31, l = (int)L;
            if (l < nfull * FULL) { const int sg = l / FULL, r = l - sg * FULL, nb = r >> 8, q = r & 255, x = q & 7, j = q >> 3;
                pml = 32 * sg + 4 * x + (j & 3); v = 8 * nb + (j >> 2); }
            else { const int r = l - nfull * FULL, x = r & 7, j = r >> 3, jq = j / remm;
                pml = 32 * nfull + (j - jq * remm); v = x + 8 * jq; }
        } else {
            int wgid = (int)L; { const int q = nwg / NXCD, r = nwg % NXCD, xcd = wgid % NXCD, off = wgid / NXCD; wgid = (xcd < r ? xcd * (q + 1) : r * (q + 1) + (xcd - r) * q) + off; }
            const int nig = WGM * nN, gid = wgid / nig, fm = gid * WGM, gsz = (nM - fm) < WGM ? (nM - fm) : WGM;
            pml = fm + ((wgid % nig) % gsz); v = (wgid % nig) / gsz; }
        u.pm = pm0 + pml; u.ks = v / nNr; u.pn = v - u.ks * nNr; int e = 0;
#pragma unroll
        for (int k = 1; k < 8; ++k) e += (u.pm >= toff[k]) ? 1 : 0;
        int tb = 0;
#pragma unroll
        for (int k = 1; k < 8; ++k) tb = (u.pm >= toff[k]) ? toff[k] : tb;
        u.be = e; u.pa = atile > 0 ? e * atile + (u.pm - tb) : u.pm; return true;
    }
    __device__ __forceinline__ void a_ready(const Unit&) const {}
    __device__ __forceinline__ void done(const Unit&) const {}
};

template <class Epi, class Sched, bool ALIGN_EPI = false, bool SP2 = false, bool FP8 = false>
__device__ __forceinline__ void gemm_phase(PG8_LAS unsigned char* lds, const Gemm g, const Sched& S, const Epi& E) {
    int tid_ = threadIdx.x; asm volatile("" : "+v"(tid_));
    const int tid = tid_, wid = __builtin_amdgcn_readfirstlane(tid >> 6), lane = tid & 63, wr = wid >> 2, wc = wid & 3, fr = lane & 15, fq = lane >> 4;
    const int K = g.K, nt = g.KL / BK; const size_t kspl = (size_t)g.KL * 2;
    unsigned voffA[2], voffB[2];
#pragma unroll
    for (int i = 0; i < 2; ++i) { int R, C; stage_rc(tid * 16 + i * 8192, R, C); const int Rb = Epi::PERM ? ((R & ~31) + perm32(R & 31)) : R;
        voffA[i] = (unsigned)(R * K + C) * 2u; voffB[i] = (unsigned)(Rb * K + C) * 2u; }
    const size_t kstep = (size_t)(BK * 2);
    const size_t hstep = (size_t)HALF * K * 2;
    const size_t tstep = 2 * hstep;
    const unsigned ldsw = (unsigned)wid * 1024u;
    const int aoff = lds_byte(wr * 64 + fr, fq * 8), boff = lds_byte(wc * 32 + fr, fq * 8);
#define PG8_SA(b, h) (((b) * 2 + (h)) * HTB)
#define PG8_SB(b, h) ((4 + (b) * 2 + (h)) * HTB)
#define PG8_STAGE(bufoff, gbase, voff) do { _Pragma("unroll") for (int _i = 0; _i < 2; ++_i) \
        __builtin_amdgcn_global_load_lds((const unsigned*)((const char*)(gbase) + (voff)[_i]), (PG8_LAS unsigned*)(lds + (bufoff) + ldsw + _i * 8192), 16, 0, 0); } while (0)
#define PG8_LDA(dst, b, h) do { if constexpr (FP8) { _Pragma("unroll") for (int m = 0; m < 4; ++m) { dst##8[m].lo = *(const PG8_LAS i32x4*)(lds + PG8_SA(b, h) + aoff + m * 2048); dst##8[m].hi = *(const PG8_LAS i32x4*)(lds + PG8_SA(b, h) + aoff + m * 2048 + 1024); } } \
        else { _Pragma("unroll") for (int m = 0; m < 4; ++m) _Pragma("unroll") for (int k = 0; k < 2; ++k) dst[m][k] = *(const PG8_LAS bf16x8*)(lds + PG8_SA(b, h) + aoff + m * 2048 + k * 1024); } } while (0)
#define PG8_LDB(dst, b, h) do { if constexpr (FP8) { _Pragma("unroll") for (int n = 0; n < 2; ++n) { dst##8[n].lo = *(const PG8_LAS i32x4*)(lds + PG8_SB(b, h) + boff + n * 2048); dst##8[n].hi = *(const PG8_LAS i32x4*)(lds + PG8_SB(b, h) + boff + n * 2048 + 1024); } } \
        else { _Pragma("unroll") for (int n = 0; n < 2; ++n) _Pragma("unroll") for (int k = 0; k < 2; ++k) dst[n][k] = *(const PG8_LAS bf16x8*)(lds + PG8_SB(b, h) + boff + n * 2048 + k * 1024); } } while (0)
#define PG8_MMA(ai, bj, At, Bt) do { __builtin_amdgcn_s_setprio(1); _Pragma("unroll") for (int m = 0; m < 4; ++m) _Pragma("unroll") for (int n = 0; n < 2; ++n) { \
        if constexpr (FP8) { asm volatile("v_mfma_f32_16x16x128_f8f6f4 %0, %1, %2, %0" : "+v"(acc[ai][bj][m][n]) : "v"(Bt##8[n]), "v"(At##8[m])); }     \
        else { _Pragma("unroll") for (int k = 0; k < 2; ++k) acc[ai][bj][m][n] = __builtin_amdgcn_mfma_f32_16x16x32_bf16(Bt[n][k], At[m][k], acc[ai][bj][m][n], 0, 0, 0); } } __builtin_amdgcn_s_setprio(0); } while (0)
#define PG8_WAIT_V(n) asm volatile("s_waitcnt vmcnt(" #n ")" ::: "memory")
#define PG8_WAIT_L(n) asm volatile("s_waitcnt lgkmcnt(" #n ")" ::: "memory")
#define PG8_BAR __builtin_amdgcn_s_barrier()
#define PG8_SCHED __builtin_amdgcn_sched_barrier(0)
    Unit cur, nxt; int ui = 0;
    if (!S.next(0, cur)) return;
    f32x4 acc[2][2][4][2];
#pragma unroll
    for (int a = 0; a < 2; ++a)
#pragma unroll
        for (int b = 0; b < 2; ++b)
#pragma unroll
            for (int m = 0; m < 4; ++m)
#pragma unroll
                for (int n = 0; n < 2; ++n) acc[a][b][m][n] = (f32x4){0.f, 0.f, 0.f, 0.f};
    bf16x8 At[4][2], B0[2][2], B1[2][2];
    i32x8 At8[4], B08[2], B18[2];
    const char* cA = (const char*)g.A + (size_t)cur.pa * tstep + (size_t)cur.ks * kspl; const char* cB = (const char*)g.Bt + (size_t)cur.be * g.bstride + (size_t)cur.pn * tstep + (size_t)cur.ks * kspl;
    S.a_ready(cur);
    if constexpr (SP2) {
        PG8_STAGE(PG8_SB(0, 0), cB, voffB); PG8_STAGE(PG8_SB(0, 1), cB + hstep, voffB); PG8_STAGE(PG8_SA(0, 0), cA, voffA); PG8_STAGE(PG8_SA(0, 1), cA + hstep, voffA);
        if (wr == 1) PG8_BAR;
        PG8_WAIT_V(2); PG8_BAR;
        PG8_STAGE(PG8_SB(1, 0), cB + kstep, voffB); PG8_STAGE(PG8_SA(1, 0), cA + kstep, voffA); PG8_STAGE(PG8_SB(1, 1), cB + hstep + kstep, voffB);
        PG8_WAIT_V(6); PG8_BAR;
    } else {
        PG8_STAGE(PG8_SB(0, 0), cB, voffB); PG8_STAGE(PG8_SA(0, 0), cA, voffA); PG8_STAGE(PG8_SB(0, 1), cB + hstep, voffB); PG8_STAGE(PG8_SA(0, 1), cA + hstep, voffA);
        if (wr == 1) PG8_BAR;
        PG8_WAIT_V(4); PG8_BAR;
        PG8_STAGE(PG8_SB(1, 0), cB + kstep, voffB); PG8_STAGE(PG8_SA(1, 0), cA + kstep, voffA); PG8_STAGE(PG8_SB(1, 1), cB + hstep + kstep, voffB);
        PG8_WAIT_V(6); PG8_BAR;
    }
    for (;;) {
        const bool has_next = S.next(ui + 1, nxt);
        const char* nA = has_next ? (const char*)g.A + (size_t)nxt.pa * tstep + (size_t)nxt.ks * kspl : cA; const char* nB = has_next ? (const char*)g.Bt + (size_t)nxt.be * g.bstride + (size_t)nxt.pn * tstep + (size_t)nxt.ks * kspl : cB;
        for (int t = 0; t < nt; t += 2) {
            const bool last = (t == nt - 2);
            const char* a1 = cA + (size_t)(t + 1) * kstep;
            const char* a2 = last ? nA : cA + (size_t)(t + 2) * kstep; const char* b2 = last ? nB : cB + (size_t)(t + 2) * kstep;
            const char* a3 = a2 + kstep; const char* b3 = b2 + kstep;
            if (last && has_next) S.a_ready(nxt);
            if constexpr (SP2) {
            PG8_LDB(B0, 0, 0); PG8_LDB(B1, 0, 1); PG8_SCHED; PG8_LDA(At, 0, 0); PG8_STAGE(PG8_SA(1, 1), a1 + hstep, voffA);
            PG8_WAIT_V(8); PG8_WAIT_L(0); PG8_BAR; PG8_MMA(0, 0, At, B0); PG8_MMA(0, 1, At, B1); PG8_BAR; PG8_SCHED;
            PG8_LDA(At, 0, 1); PG8_STAGE(PG8_SB(0, 0), b2, voffB); PG8_STAGE(PG8_SB(0, 1), b2 + hstep, voffB); PG8_STAGE(PG8_SA(0, 0), a2, voffA);
            PG8_WAIT_V(8); PG8_WAIT_L(0); PG8_BAR; PG8_MMA(1, 0, At, B0); PG8_MMA(1, 1, At, B1); PG8_BAR; PG8_SCHED;
            PG8_LDB(B0, 1, 0); PG8_LDB(B1, 1, 1); PG8_SCHED; PG8_LDA(At, 1, 0); PG8_STAGE(PG8_SA(0, 1), a2 + hstep, voffA);
            PG8_WAIT_V(8); PG8_WAIT_L(0); PG8_BAR; PG8_MMA(0, 0, At, B0); PG8_MMA(0, 1, At, B1); PG8_BAR; PG8_SCHED;
            PG8_LDA(At, 1, 1); PG8_STAGE(PG8_SB(1, 0), b3, voffB); PG8_STAGE(PG8_SB(1, 1), b3 + hstep, voffB); PG8_STAGE(PG8_SA(1, 0), a3, voffA);
            PG8_WAIT_V(8); PG8_WAIT_L(0); PG8_BAR; PG8_MMA(1, 0, At, B0); PG8_MMA(1, 1, At, B1); PG8_BAR; PG8_SCHED;
            } else {
            PG8_LDB(B0, 0, 0); PG8_SCHED; PG8_LDA(At, 0, 0); PG8_STAGE(PG8_SA(1, 1), a1 + hstep, voffA);
            PG8_WAIT_L(8); PG8_BAR; PG8_WAIT_L(0); PG8_MMA(0, 0, At, B0); PG8_BAR; PG8_SCHED;
            PG8_LDB(B1, 0, 1); PG8_STAGE(PG8_SB(0, 0), b2, voffB);
            PG8_BAR; PG8_WAIT_L(0); PG8_MMA(0, 1, At, B1); PG8_BAR;
            PG8_LDA(At, 0, 1); PG8_STAGE(PG8_SA(0, 0), a2, voffA);
            PG8_BAR; PG8_WAIT_L(0); PG8_MMA(1, 0, At, B0); PG8_BAR; PG8_SCHED;
            PG8_STAGE(PG8_SB(0, 1), b2 + hstep, voffB);
            PG8_WAIT_V(6); PG8_BAR; PG8_MMA(1, 1, At, B1); PG8_BAR;
            PG8_LDB(B0, 1, 0); PG8_SCHED; PG8_LDA(At, 1, 0); PG8_STAGE(PG8_SA(0, 1), a2 + hstep, voffA);
            PG8_WAIT_L(8); PG8_BAR; PG8_WAIT_L(0); PG8_MMA(0, 0, At, B0); PG8_BAR; PG8_SCHED;
            PG8_LDB(B1, 1, 1); PG8_STAGE(PG8_SB(1, 0), b3, voffB);
            PG8_BAR; PG8_WAIT_L(0); PG8_MMA(0, 1, At, B1); PG8_BAR;
            PG8_LDA(At, 1, 1); PG8_STAGE(PG8_SA(1, 0), a3, voffA);
            PG8_BAR; PG8_WAIT_L(0); PG8_MMA(1, 0, At, B0); PG8_BAR; PG8_SCHED;
            PG8_STAGE(PG8_SB(1, 1), b3 + hstep, voffB);
            PG8_WAIT_V(6); PG8_BAR; PG8_MMA(1, 1, At, B1); PG8_BAR;
            }
        }
        if constexpr (ALIGN_EPI) { if (wr == 0) PG8_BAR; }
        if constexpr (FP8) { asm volatile("s_nop 15\n\ts_nop 15" ::: "memory"); }
        if constexpr (!Epi::AFTER_DRAIN) { E(acc, cur, wr, wc, fr, fq); S.done(cur); }
        if (!has_next) break;
#pragma unroll
        for (int a = 0; a < 2; ++a)
#pragma unroll
            for (int b = 0; b < 2; ++b)
#pragma unroll
                for (int m = 0; m < 4; ++m)
#pragma unroll
                    for (int n = 0; n < 2; ++n) acc[a][b][m][n] = (f32x4){0.f, 0.f, 0.f, 0.f};
        cur = nxt; cA = nA; cB = nB; ++ui;
        if constexpr (ALIGN_EPI) { if (wr == 1) PG8_BAR; }
    }
    PG8_WAIT_V(0);
    if constexpr (!ALIGN_EPI) { if (wr == 0) PG8_BAR; }
    PG8_BAR;
    if constexpr (Epi::AFTER_DRAIN) { E.fused(acc, cur, wr, wc, fr, fq, lds, wid, lane); S.done(cur); }
#undef PG8_SA
#undef PG8_SB
#undef PG8_STAGE
#undef PG8_LDA
#undef PG8_LDB
#undef PG8_MMA
#undef PG8_WAIT_V
#undef PG8_WAIT_L
#undef PG8_BAR
#undef PG8_SCHED
}
}
constexpr int NWAVES = 8;
constexpr int DM = 2048, SEQ = 8192, NBATCH = 2, CTXL = 256;
constexpr int ML = NBATCH * SEQ, MC = NBATCH * CTXL, MT = ML + MC;
constexpr int EIN = 4608, DFF = 5632, DFFE = 7168, NEXP = 8;
constexpr int MOD_W = 6 * DM;
constexpr int CAP = 2 * ML + NEXP * 256;
constexpr float NORM_EPS = 1e-6f;
constexpr int Y2_FULL_TILES = 128, Y2_PART_ROWS = 8 * 256;
static_assert((size_t)7 * Y2_PART_ROWS * DM * 2 <= (size_t)MT * DM * 2, "the partials fit the XN region");
constexpr int NCHUNK = ML / 64 + MC / 64;

constexpr size_t MiB = 1u << 20;
constexpr size_t al(size_t x) { return (x + MiB - 1) / MiB * MiB; }
constexpr size_t WS_CTL = 0, CTL_ZERO_BYTES = 1 * MiB;
constexpr size_t WS_MOD0 = 1 * MiB;
constexpr size_t WS_MOD1 = WS_MOD0 + 3 * MOD_W * 4;
constexpr size_t WS_ROPE = WS_MOD1 + 3 * MOD_W * 4;
constexpr size_t WS_ROUTE = 2 * MiB;
constexpr size_t WS_SUM = 3 * MiB;
constexpr size_t WS_CARRY = WS_SUM + al((size_t)NCHUNK * 2 * DM * 8);
constexpr size_t WS_HC = WS_CARRY + al((size_t)256 * 2 * DM * 4);
constexpr size_t WS_WIN0 = WS_HC + al((size_t)MC * DM * 4);
constexpr size_t WS_WOUT0 = WS_WIN0 + al((size_t)EIN * DM * 2);
constexpr size_t WS_WGU0 = WS_WOUT0 + al((size_t)DM * DM * 2);
constexpr size_t WS_WD0 = WS_WGU0 + al((size_t)2 * DFF * DM * 2);
constexpr size_t WS_WIN1 = WS_WD0 + al((size_t)DM * DFF * 2);
constexpr size_t WS_WGT = WS_WIN1 + al((size_t)2 * DM * DM * 2);
constexpr size_t WS_WOUT1 = WS_WGT + al((size_t)64 * 128 * 128 * 2);
constexpr size_t WS_MWGU = WS_WOUT1 + al((size_t)DM * DM * 2);
constexpr size_t WS_MWD = WS_MWGU + al((size_t)NEXP * 2 * DFFE * DM);
constexpr size_t WS_XN = WS_MWD + al((size_t)NEXP * DM * DFFE);
constexpr size_t WS_AO = WS_XN + al((size_t)MT * DM * 2);
constexpr size_t WS_VT = WS_AO + al((size_t)MT * DM * 2);
constexpr size_t WS_Z = WS_VT + al((size_t)(ML + MC) * 256 * 2);
constexpr size_t WS_HID = WS_Z + al((size_t)MT * EIN * 2);
constexpr size_t WS_H = WS_HID + al((size_t)CAP * DFFE * 2);
constexpr size_t WS_XGS = WS_H + al((size_t)MT * DM * 2);
constexpr size_t WS_END = WS_XGS + al((size_t)NEXP * ML * DM);
static_assert((size_t)CAP * DM * 2 <= (size_t)MT * EIN * 2, "XG fits the Z region");
static_assert(WS_Z - WS_XN >= (size_t)CAP * DM * 2, "split-K partial buffer 0 fits XN|AO|VT");
constexpr int CW_TMO = 0, CW_CODE = 1;
constexpr int CW_BAR = 4096;
constexpr int CW_BAR2 = 16384;
constexpr int CW_CNT = 8192;
constexpr int CW_QHEAD = 8256;
constexpr int CW_DONE = 8320;
constexpr int CW_W13 = 8320;

constexpr int RING_BYTES = 131072;
constexpr int SCR_BYTES = 151552;
constexpr int MISC_OFF = SCR_BYTES;
constexpr int LDS_BYTES = 155648;

#define GAS __attribute__((address_space(1)))
#define LAS __attribute__((address_space(3)))
typedef unsigned short bf16;
typedef unsigned v4u __attribute__((ext_vector_type(4)));
typedef unsigned v2u __attribute__((ext_vector_type(2)));
typedef float f32x4 __attribute__((ext_vector_type(4)));
typedef float f32x16 __attribute__((ext_vector_type(16)));
typedef short bf16x8 __attribute__((ext_vector_type(8)));
typedef GAS unsigned gu32;
#define RLX_AGENT __ATOMIC_RELAXED, __HIP_MEMORY_SCOPE_AGENT
#define LDS_WAIT() asm volatile("s_waitcnt lgkmcnt(0)" ::: "memory")
#define VM_WAIT() asm volatile("s_waitcnt vmcnt(0)" ::: "memory")
#define LDS_BARRIER() do { asm volatile("s_waitcnt lgkmcnt(0)" ::: "memory"); __builtin_amdgcn_s_barrier(); asm volatile("" ::: "memory"); } while (0)
__device__ __forceinline__ unsigned f2bf(float f) { unsigned u = __builtin_bit_cast(unsigned, f); return (u + 0x7fffu + ((u >> 16) & 1u)) >> 16; }
__device__ __forceinline__ unsigned pk2(float lo, float hi) { return pg8::cvt_pk_bf16(lo, hi); }
__device__ __forceinline__ float bflo(unsigned w) { return __builtin_bit_cast(float, w << 16); }
__device__ __forceinline__ float bfhi(unsigned w) { return __builtin_bit_cast(float, w & 0xffff0000u); }
__device__ __forceinline__ float wave_sum(float v) {
#pragma unroll
    for (int o = 1; o < 64; o <<= 1) v += __shfl_xor(v, o);
    return v;
}

#define XB_TMO      128
#define XB_XCNT(j)  (256  + 64 * (j))
#define XB_XSUB(j)  (1280 + 64 * (j))
#define XB_XGEN(j)  (2304 + 64 * (j))
#define XB_TOP      3328
#define XB_TOPGEN   3392
#define XCD_BAR_WORDS 3456
#define XB_SPIN_CAP (1u << 18)

__device__ __forceinline__ unsigned xb_ld(unsigned* p)              { return __hip_atomic_load(p, __ATOMIC_RELAXED, __HIP_MEMORY_SCOPE_AGENT); }
__device__ __forceinline__ unsigned xb_add(unsigned* p, unsigned v) { return __hip_atomic_fetch_add(p, v, __ATOMIC_RELAXED, __HIP_MEMORY_SCOPE_AGENT); }
__device__ __forceinline__ unsigned xb_xcc_id() { return (unsigned)__builtin_amdgcn_s_getreg((3 << 11) | 20) & 0xFu; }
#define XB_SPIN(cond, bar) do { unsigned _sp = 0; while (cond) { __builtin_amdgcn_s_sleep(1); \
    if ((++_sp & 255u) == 0u) { if (xb_ld(&(bar)[XB_TMO])) break; if (_sp > XB_SPIN_CAP) { atomicAdd(&(bar)[XB_TMO], 1u); break; } } } } while (0)

struct XcdBarrier {
    unsigned* bar; unsigned x; unsigned total;
    volatile LAS unsigned* st;
};

__device__ __forceinline__ XcdBarrier xcd_barrier_post(unsigned* bar, volatile LAS unsigned* st, unsigned total) {
    XcdBarrier b; b.bar = bar; b.x = xb_xcc_id(); b.st = st; b.total = total;
    if (threadIdx.x == 0) (void)xb_add(&bar[XB_XCNT(b.x)], 1u);
    return b;
}
__device__ __forceinline__ void xcd_barrier_complete(unsigned* bar, unsigned x, unsigned G, unsigned& nloc, unsigned& nx) {
    unsigned sum, cnt, mine, sp = 0u;
    for (;;) {
        sum = 0u; cnt = 0u; mine = 0u;
#pragma unroll
        for (unsigned j = 0; j < 16; ++j) { const unsigned c = xb_ld(&bar[XB_XCNT(j)]); sum += c; cnt += (c > 0u) ? 1u : 0u; mine = (j == x) ? c : mine; }
        if (sum == G) break;
        __builtin_amdgcn_s_sleep(1);
        if ((++sp & 255u) == 0u) { if (xb_ld(&bar[XB_TMO])) break; if (sp > XB_SPIN_CAP) { atomicAdd(&bar[XB_TMO], 1u); break; } }
    }
    nloc = mine > 0u ? mine : 1u; nx = cnt > 0u ? cnt : 1u;
}

__device__ __forceinline__ void xcd_barrier(const XcdBarrier& b) {
    asm volatile("s_waitcnt vmcnt(0)" ::: "memory");
    __syncthreads();
    if (threadIdx.x == 0) {
        unsigned* bar = b.bar;
        __builtin_amdgcn_s_waitcnt(0);
        unsigned nloc = b.st[0], nx = b.st[1];
        if (nloc == 0u) { xcd_barrier_complete(bar, b.x, b.total, nloc, nx); b.st[0] = nloc; b.st[1] = nx; }
        const unsigned old = xb_add(&bar[XB_XSUB(b.x)], 1u);
        const unsigned gen = old / nloc;
        if (old + 1u == (gen + 1u) * nloc) {
            __builtin_amdgcn_fence(__ATOMIC_RELEASE, "agent");
            asm volatile("s_waitcnt vmcnt(0)" ::: "memory");
            const unsigned og = xb_add(&bar[XB_TOP], 1u);
            const unsigned tg = og / nx;
            if (og + 1u == (tg + 1u) * nx) xb_add(&bar[XB_TOPGEN], 1u);
            else XB_SPIN(xb_ld(&bar[XB_TOPGEN]) == tg, bar);
            __builtin_amdgcn_fence(__ATOMIC_ACQUIRE, "agent");
            xb_add(&bar[XB_XGEN(b.x)], 1u);
            asm volatile("s_waitcnt vmcnt(0)" ::: "memory");
        } else {
            XB_SPIN(xb_ld(&bar[XB_XGEN(b.x)]) == gen, bar);
            __builtin_amdgcn_fence(__ATOMIC_ACQUIRE, "agent");
            asm volatile("s_waitcnt vmcnt(0)" ::: "memory");
        }
    }
    __syncthreads();
}

struct Args { const float* in[35]; float* out; unsigned char* ws; int ph_lo, ph_hi; };
struct Frame {
    LAS unsigned char* lds;
    gu32* ctl;
    int tid, lane, wave, vcu, G;
    const float* const* in; float* out; unsigned char* ws;
};
#define WSP(T, off) ((T*)(F.ws + (off)))

__device__ __forceinline__ void tr_item(const float* W, int ldw, int k0, int n0, bf16* WT, int ldt, int dst_row0, LAS float* scr, int lane) {
    const int rr = lane >> 4, c4 = (lane & 15) * 4;
    f32x4 v[16];
#pragma unroll
    for (int i = 0; i < 16; ++i) v[i] = *(const GAS f32x4*)(W + (size_t)(k0 + 4 * i + rr) * ldw + n0 + c4);
#pragma unroll
    for (int i = 0; i < 16; ++i) { LAS float* p = scr + (4 * i + rr) * 65 + c4; p[0] = v[i].x; p[1] = v[i].y; p[2] = v[i].z; p[3] = v[i].w; }
    LDS_WAIT(); asm volatile("" ::: "memory");
    const int kc = lane & 7, nn = lane >> 3;
#pragma unroll
    for (int j = 0; j < 8; ++j) { const int n = nn + 8 * j; const LAS float* s = scr + (8 * kc) * 65 + n;
        v4u o; o.x = pk2(s[0 * 65], s[1 * 65]); o.y = pk2(s[2 * 65], s[3 * 65]); o.z = pk2(s[4 * 65], s[5 * 65]); o.w = pk2(s[6 * 65], s[7 * 65]);
        *(GAS v4u*)(WT + (size_t)(dst_row0 + n) * ldt + k0 + 8 * kc) = o; }
    LDS_WAIT(); asm volatile("" ::: "memory");
}
__device__ __forceinline__ void tr_matrix_item(const float* W, int K, int N, bf16* WT, int mode, int item, LAS float* scr, int lane) {
    const int nb = N / 64, kb = item / nb, nbi = item % nb, k0 = kb * 64, n0 = nbi * 64;
    const int dr = mode == 0 ? n0 : (256 * (n0 >> 7) + (n0 & 127) + (mode == 2 ? 128 : 0));
    tr_item(W, N, k0, n0, WT, K, dr, scr, lane);
}
__device__ __forceinline__ float silu_f(float x) { return x / (1.0f + __expf(-x)); }
__device__ __forceinline__ void adaln_item(Frame& F, const float* wmod, const float* bmod, float* mod, int slab) {
    const float* c = F.in[1]; const float* cc = F.in[3];
    const int c4 = F.tid & 31, kg = F.tid >> 5, n0 = slab * 128 + c4 * 4;
    LAS float* sl = (LAS float*)(F.lds + 32768);
    for (int i = F.tid; i < 3 * DM; i += NWAVES * 64) { const float x = i < 2 * DM ? c[i] : cc[i - 2 * DM]; sl[i] = silu_f(x); }
    __syncthreads();
    f32x4 a0 = {0.f, 0.f, 0.f, 0.f}, a1 = a0, a2 = a0;
#pragma unroll 16
    for (int i = 0; i < 128; ++i) { const int k = kg + 16 * i; const f32x4 w = __builtin_nontemporal_load((const GAS f32x4*)(wmod + (size_t)k * MOD_W + n0));
        const float s0 = sl[k], s1 = sl[DM + k], s2 = sl[2 * DM + k]; a0 += w * s0; a1 += w * s1; a2 += w * s2; }
    LAS float* red = (LAS float*)F.lds;
    *(LAS f32x4*)(red + (kg * 3 + 0) * 128 + c4 * 4) = a0; *(LAS f32x4*)(red + (kg * 3 + 1) * 128 + c4 * 4) = a1; *(LAS f32x4*)(red + (kg * 3 + 2) * 128 + c4 * 4) = a2;
    __syncthreads();
    if (F.tid < 384) { const int v = F.tid >> 7, col = F.tid & 127; float s = bmod[slab * 128 + col];
#pragma unroll
        for (int g = 0; g < 16; ++g) s += red[(g * 3 + v) * 128 + col];
        mod[(size_t)v * MOD_W + slab * 128 + col] = s; }
    __syncthreads();
}
constexpr int I_WIN0 = 32 * 72, I_SQ = 32 * 32, I_F = 32 * 88, I_WIN1 = 32 * 64, I_G = 4, I_ME = 32 * 112;
constexpr int NDENSE = I_WIN0 + I_SQ + 3 * I_F + I_WIN1 + I_SQ + 64 * I_G, NITEMS = NDENSE + 24 * I_ME;
#ifndef MK_FFN8
#define MK_FFN8 1
#endif
constexpr int FFN8 = MK_FFN8;
struct CvItem { const float* src; bf16* dst; int ldw, ldt, f8; };
constexpr float W8_SCALE = 64.0f;
__device__ __forceinline__ unsigned pk4_fp8(float a, float b, float c, float d) { int p = 0; p = __builtin_amdgcn_cvt_pk_fp8_f32(a, b, p, false); p = __builtin_amdgcn_cvt_pk_fp8_f32(c, d, p, true); return (unsigned)p; }
__device__ __forceinline__ float clamp8(float x) { return __builtin_fminf(__builtin_fmaxf(x, -448.0f), 448.0f); }
__device__ __forceinline__ CvItem cv_make(const float* W, int K, int N, bf16* WT, int mode, int sub, int f8 = 0) {
    const int nb = N / 32, kb = sub / nb, nbi = sub % nb, k0 = kb * 128, n0 = nbi * 32;
    const int dr = mode == 0 ? n0 : (256 * (n0 >> 7) + (n0 & 127) + (mode == 2 ? 128 : 0));
    CvItem m; m.src = W + (size_t)k0 * N + n0; m.ldw = N; m.f8 = f8;
    if (f8) { m.dst = (bf16*)((unsigned char*)WT + (size_t)dr * K + k0); m.ldt = K; } else { m.dst = WT + (size_t)dr * K + k0; m.ldt = K; }
    return m;
}
__device__ __forceinline__ CvItem cv_item(Frame& F, int it) {
    int r = it;
    if (r < I_WIN0) return cv_make(F.in[7], DM, EIN, WSP(bf16, WS_WIN0), 0, r); r -= I_WIN0;
    if (r < I_SQ) return cv_make(F.in[11], DM, DM, WSP(bf16, WS_WOUT0), 0, r); r -= I_SQ;
    if (r < I_F) return cv_make(F.in[13], DM, DFF, WSP(bf16, WS_WGU0), 1, r, FFN8); r -= I_F;
    if (r < I_F) return cv_make(F.in[14], DM, DFF, WSP(bf16, WS_WGU0), 2, r, FFN8); r -= I_F;
    if (r < I_F) return cv_make(F.in[15], DFF, DM, WSP(bf16, WS_WD0), 0, r, FFN8); r -= I_F;
    if (r < I_WIN1) return cv_make(F.in[19], DM, 2 * DM, WSP(bf16, WS_WIN1), 0, r); r -= I_WIN1;
    if (r < I_SQ) return cv_make(F.in[27], DM, DM, WSP(bf16, WS_WOUT1), 0, r); r -= I_SQ;
    if (r < 64 * I_G) { const int mtx = r >> 2, sub = r & 3, gt = mtx >> 5, zh = mtx & 31, z = zh >> 4, h = zh & 15;
        return cv_make(F.in[gt ? 24 : 22] + (size_t)zh * 16384, 128, 128, WSP(bf16, WS_WGT) + (size_t)((z * 2 + gt) * 16 + h) * 16384, 0, sub); } r -= 64 * I_G;
    const int w = r / (8 * I_ME), rr = r % (8 * I_ME), e = rr / I_ME, sub = rr % I_ME;
    if (w == 0) return cv_make(F.in[31] + (size_t)e * DM * DFFE, DM, DFFE, (bf16*)(F.ws + WS_MWGU + (size_t)e * 2 * DFFE * DM), 1, sub, 1);
    if (w == 1) return cv_make(F.in[32] + (size_t)e * DM * DFFE, DM, DFFE, (bf16*)(F.ws + WS_MWGU + (size_t)e * 2 * DFFE * DM), 2, sub, 1);
    return cv_make(F.in[33] + (size_t)e * DFFE * DM, DFFE, DM, (bf16*)(F.ws + WS_MWD + (size_t)e * DM * DFFE), 0, sub, 1);
}
__device__ __forceinline__ void cv_load(const CvItem& m, int lane, f32x4 (&v)[16]) {
    const int rr = lane >> 3, c4 = (lane & 7) * 4;
#pragma unroll
    for (int i = 0; i < 16; ++i) v[i] = __builtin_nontemporal_load((const GAS f32x4*)(m.src + (size_t)(8 * i + rr) * m.ldw + c4));
}
__device__ __forceinline__ float clamp8s(float x) { return __builtin_amdgcn_fmed3f(x * W8_SCALE, -448.0f, 448.0f); }
__device__ __forceinline__ void cv_finish(const CvItem& m, int lane, const f32x4 (&v)[16], LAS float* scr) {
    const int rr = lane >> 3, c4 = (lane & 7) * 4;
#pragma unroll
    for (int i = 0; i < 16; ++i) *(LAS f32x4*)(scr + (8 * i + rr) * 36 + (c4 ^ (4 * ((i >> 1) & 7)))) = v[i];
    LDS_WAIT(); asm volatile("" ::: "memory");
    const int kc = lane & 7, nn = lane >> 3;
#pragma unroll
    for (int j = 0; j < 4; ++j) { const int n = nn + 8 * j; const LAS float* s = scr + (16 * kc) * 36 + (n ^ (4 * kc));
        float x[16];
#pragma unroll
        for (int q = 0; q < 16; ++q) x[q] = s[q * 36];
        if (m.f8) { v4u o;
            o.x = pk4_fp8(clamp8s(x[0]), clamp8s(x[1]), clamp8s(x[2]), clamp8s(x[3])); o.y = pk4_fp8(clamp8s(x[4]), clamp8s(x[5]), clamp8s(x[6]), clamp8s(x[7]));
            o.z = pk4_fp8(clamp8s(x[8]), clamp8s(x[9]), clamp8s(x[10]), clamp8s(x[11])); o.w = pk4_fp8(clamp8s(x[12]), clamp8s(x[13]), clamp8s(x[14]), clamp8s(x[15]));
            __builtin_nontemporal_store(o, (GAS v4u*)((unsigned char*)m.dst + (size_t)n * m.ldt + 16 * kc)); }
        else { v4u o0, o1; o0.x = pk2(x[0], x[1]); o0.y = pk2(x[2], x[3]); o0.z = pk2(x[4], x[5]); o0.w = pk2(x[6], x[7]); o1.x = pk2(x[8], x[9]); o1.y = pk2(x[10], x[11]); o1.z = pk2(x[12], x[13]); o1.w = pk2(x[14], x[15]);
            GAS v4u* d = (GAS v4u*)(m.dst + (size_t)n * m.ldt + 16 * kc); __builtin_nontemporal_store(o0, d); __builtin_nontemporal_store(o1, d + 1); } }
    LDS_WAIT(); asm volatile("" ::: "memory");
}
constexpr int NEARLY = I_WIN0 + I_SQ + 3 * I_F;
constexpr int NQ = NITEMS - NEARLY, NQ_LATE = I_WIN1 + I_SQ + 64 * I_G;
__device__ __forceinline__ void convert_dense(Frame& F) {
    LAS float* scr = (LAS float*)(F.lds + F.wave * 18432);
    const int NW = F.G * NWAVES; int r = F.vcu * NWAVES + F.wave;
    f32x4 va[16], vb[16]; CvItem ma, mb;
    if (r < NEARLY) { ma = cv_item(F, r); cv_load(ma, F.lane, va); }
#pragma unroll 1
    for (; r < NEARLY; r += 2 * NW) {
        const bool hb = r + NW < NEARLY;
        if (hb) { mb = cv_item(F, r + NW); cv_load(mb, F.lane, vb); }
        cv_finish(ma, F.lane, va, scr);
        if (r + 2 * NW < NEARLY) { ma = cv_item(F, r + 2 * NW); cv_load(ma, F.lane, va); }
        if (hb) cv_finish(mb, F.lane, vb, scr);
    }
}
__device__ __forceinline__ void moe_pull(Frame& F, int k, int until) {
    LAS int* q = (LAS int*)(F.lds + MISC_OFF + 64);
    LAS float* scr = (LAS float*)(F.lds + F.wave * 18432);
    gu32* qhead = F.ctl + CW_QHEAD; gu32* done = F.ctl + CW_DONE + 64 * (k < 0 ? 0 : k);
    bool first = true;
    for (;;) {
        __syncthreads();
        if (F.tid == 0) {
            if (first && k >= 0) __hip_atomic_fetch_add(done, 1u, RLX_AGENT);
            const bool go = k < 0 ? (int)__hip_atomic_load(qhead, RLX_AGENT) < until : (int)__hip_atomic_load(done, RLX_AGENT) < F.G;
            int f = -1; if (go) { f = (int)__hip_atomic_fetch_add(qhead, 64u, RLX_AGENT); if (f >= NQ) f = -1; }
            q[0] = f;
        }
        first = false;
        __syncthreads();
        const int f0 = q[0];
        if (f0 < 0) break;
        const int f = f0 + 8 * F.wave;
        f32x4 va[16], vb[16]; CvItem ma, mb;
        if (f < NQ) { ma = cv_item(F, NEARLY + f); cv_load(ma, F.lane, va); }
#pragma unroll 1
        for (int t = 0; t < 8; t += 2) {
            if (f + t + 1 < NQ) { mb = cv_item(F, NEARLY + f + t + 1); cv_load(mb, F.lane, vb); }
            if (f + t < NQ) cv_finish(ma, F.lane, va, scr);
            if (t + 2 < 8 && f + t + 2 < NQ) { ma = cv_item(F, NEARLY + f + t + 2); cv_load(ma, F.lane, va); }
            if (f + t + 1 < NQ) cv_finish(mb, F.lane, vb, scr);
        }
    }
}
__device__ __forceinline__ void p0_prologue(Frame& F) {
    for (int it = F.vcu; it < 192; it += F.G) { const int layer = it / 96, slab = it % 96;
        adaln_item(F, F.in[layer ? 16 : 4], F.in[layer ? 17 : 5], WSP(float, layer ? WS_MOD1 : WS_MOD0), slab); }
    { const int gt = F.vcu * 512 + F.tid; if (gt < 192 * 32) { const int pos = gt >> 5, i = gt & 31; const float inv = powf(10000.0f, -(float)i / 32.0f);
        const float ang = (float)(pos < 128 ? pos : pos - 128) * inv; float* rp = WSP(float, WS_ROPE); rp[gt] = cosf(ang); rp[192 * 32 + gt] = sinf(ang); } }
    __syncthreads();
    convert_dense(F);
}

template <bool F8, bool SRCH = false> __device__ __forceinline__ void norm_phase(Frame& F, const float* srcL, const float* srcC, const float* g, const float* mod, int shift_off, int scale_off, int nrows) {
    const int gw = F.vcu * NWAVES + F.wave, NGW = F.G * NWAVES;
    bf16* XN = WSP(bf16, WS_XN);
    for (int row = gw; row < nrows; row += NGW) {
        const float* src = row < ML ? srcL + (size_t)row * DM : srcC + (size_t)(row - ML) * DM;
        const float* mv = mod + (size_t)(row < ML ? (row >> 13) : 2) * MOD_W;
        const GAS f32x4* xr = (const GAS f32x4*)src + F.lane;
        f32x4 v[8]; float s = 0.f;
#pragma unroll
        for (int j = 0; j < 8; ++j) {
            if constexpr (SRCH) { const v2u w = ((const GAS v2u*)(WSP(const bf16, WS_H) + (size_t)row * DM))[F.lane + 64 * j]; v[j].x = bflo(w.x); v[j].y = bfhi(w.x); v[j].z = bflo(w.y); v[j].w = bfhi(w.y); }
            else v[j] = xr[64 * j];
            s += (v[j].x * v[j].x + v[j].y * v[j].y) + (v[j].z * v[j].z + v[j].w * v[j].w); }
        const float rstd = 1.0f / sqrtf(wave_sum(s) * (1.0f / DM) + NORM_EPS);
        GAS v2u* o8 = (GAS v2u*)(XN + (size_t)row * DM) + F.lane;
#pragma unroll
        for (int j = 0; j < 8; ++j) { const int col = 4 * (F.lane + 64 * j);
            const f32x4 gg = *(const GAS f32x4*)(g + col), sh = *(const GAS f32x4*)(mv + shift_off + col), sc = *(const GAS f32x4*)(mv + scale_off + col);
            const f32x4 y = v[j] * rstd * gg * (sc + 1.0f) + sh;
            if (F8) { ((GAS unsigned*)((unsigned char*)XN + (size_t)row * DM))[F.lane + 64 * j] = pk4_fp8(clamp8(y.x), clamp8(y.y), clamp8(y.z), clamp8(y.w)); }
            else { v2u w; w.x = pk2(y.x, y.y); w.y = pk2(y.z, y.w); o8[64 * j] = w; } }
    }
}
__device__ __forceinline__ void rope_conv_phase(Frame& F) {
    const int gw = F.vcu * NWAVES + F.wave, NGW = F.G * NWAVES;
    bf16* Z = WSP(bf16, WS_Z); bf16* AO = WSP(bf16, WS_AO); const float* rope = WSP(const float, WS_ROPE);
    const float* cw = F.in[9]; const float* cb = F.in[10];
    for (int row = gw; row < MT; row += NGW) {
        bf16* zr = Z + (size_t)row * EIN;
        if (row < ML) {
            const int t = row & (SEQ - 1);
#pragma unroll
            for (int ps = 0; ps < 3; ++ps) { const int li = ps * 64 + F.lane;
                if (li < 160) { const int hd = li >> 4, sub = li & 15, half = sub >> 3, d4 = (sub & 7) * 4;
                    const int col = (hd < 8 ? hd * 128 : 1024 + (hd - 8) * 128) + half * 64 + d4;
                    const int pos = half ? 128 + (t & 63) : (t >> 6);
                    const f32x4 cs = *(const GAS f32x4*)(rope + pos * 32 + d4), sn = *(const GAS f32x4*)(rope + 192 * 32 + pos * 32 + d4);
                    const v2u a = *(const GAS v2u*)(zr + col), b = *(const GAS v2u*)(zr + col + 32);
                    const float x0 = bflo(a.x), x1 = bfhi(a.x), x2 = bflo(a.y), x3 = bfhi(a.y), y0 = bflo(b.x), y1 = bfhi(b.x), y2 = bflo(b.y), y3 = bfhi(b.y);
                    v2u oa, ob; oa.x = pk2(x0 * cs.x - y0 * sn.x, x1 * cs.y - y1 * sn.y); oa.y = pk2(x2 * cs.z - y2 * sn.z, x3 * cs.w - y3 * sn.w);
                    ob.x = pk2(y0 * cs.x + x0 * sn.x, y1 * cs.y + x1 * sn.y); ob.y = pk2(y2 * cs.z + x2 * sn.z, y3 * cs.w + x3 * sn.w);
                    *(GAS v2u*)(zr + col) = oa; *(GAS v2u*)(zr + col + 32) = ob; } }
        }
        const int tt = row < ML ? (row & (SEQ - 1)) : ((row - ML) & (CTXL - 1)); const int tlen = row < ML ? SEQ : CTXL;
        const bool hp = tt > 0, hn = tt < tlen - 1;
#pragma unroll
        for (int ps = 0; ps < 2; ++ps) { const int ch = (ps * 64 + F.lane) * 8;
            const v4u z4 = {0u, 0u, 0u, 0u};
            const v4u xc_ = *(const GAS v4u*)(zr + 1536 + ch), gc_ = *(const GAS v4u*)(zr + 3584 + ch), bg = *(const GAS v4u*)(zr + 2560 + ch);
            const v4u xp = hp ? *(const GAS v4u*)(zr - EIN + 1536 + ch) : z4, gp = hp ? *(const GAS v4u*)(zr - EIN + 3584 + ch) : z4;
            const v4u xn = hn ? *(const GAS v4u*)(zr + EIN + 1536 + ch) : z4, gn = hn ? *(const GAS v4u*)(zr + EIN + 3584 + ch) : z4;
            float o[8];
#pragma unroll
            for (int j = 0; j < 4; ++j) {
#pragma unroll
                for (int e = 0; e < 2; ++e) { const int c = ch + 2 * j + e;
                    const float up = e ? bfhi(xp[j]) * bfhi(gp[j]) : bflo(xp[j]) * bflo(gp[j]);
                    const float uc = e ? bfhi(xc_[j]) * bfhi(gc_[j]) : bflo(xc_[j]) * bflo(gc_[j]);
                    const float un = e ? bfhi(xn[j]) * bfhi(gn[j]) : bflo(xn[j]) * bflo(gn[j]);
                    const float bgv = e ? bfhi(bg[j]) : bflo(bg[j]);
                    o[2 * j + e] = bgv * (cb[c] + cw[c] * up + cw[1024 + c] * uc + cw[2048 + c] * un); } }
            v4u w; w.x = pk2(o[0], o[1]); w.y = pk2(o[2], o[3]); w.z = pk2(o[4], o[5]); w.w = pk2(o[6], o[7]);
            *(GAS v4u*)(AO + (size_t)row * DM + 1024 + ch) = w; }
    }
    LAS unsigned short* scr = (LAS unsigned short*)(F.lds + F.wave * 16640);
    bf16* VT = WSP(bf16, WS_VT);
    for (int it = gw; it < (MT / 64) * 2; it += NGW) { const int kvh = it & 1, blk = it >> 1, row0 = blk * 64;
        const int rr = F.lane >> 4, c8 = (F.lane & 15) * 8;
#pragma unroll
        for (int i = 0; i < 16; ++i) { const v4u v = *(const GAS v4u*)(Z + (size_t)(row0 + 4 * i + rr) * EIN + 1280 + kvh * 128 + c8);
            LAS unsigned* p = (LAS unsigned*)(scr + (4 * i + rr) * 130 + c8); p[0] = v.x; p[1] = v.y; p[2] = v.z; p[3] = v.w; }
        LDS_WAIT(); asm volatile("" ::: "memory");
        const bool isc = row0 >= ML; const int bb = isc ? (row0 - ML) >> 8 : row0 >> 13, t0 = isc ? (row0 - ML) & 255 : row0 & (SEQ - 1), tl = isc ? CTXL : SEQ;
        bf16* dst = VT + (isc ? (size_t)ML * 256 : 0) + (size_t)(bb * 2 + kvh) * 128 * tl + t0;
        const int tc = F.lane & 7, dd = F.lane >> 3;
#pragma unroll
        for (int j = 0; j < 16; ++j) { const int d = dd + 8 * j; const LAS unsigned short* s = scr + (8 * tc) * 130 + d;
            v4u o; o.x = (unsigned)s[0] | ((unsigned)s[130] << 16); o.y = (unsigned)s[2 * 130] | ((unsigned)s[3 * 130] << 16);
            o.z = (unsigned)s[4 * 130] | ((unsigned)s[5 * 130] << 16); o.w = (unsigned)s[6 * 130] | ((unsigned)s[7 * 130] << 16);
            *(GAS v4u*)(dst + (size_t)d * tl + 8 * tc) = o; }
        LDS_WAIT(); asm volatile("" ::: "memory");
    }
}

__device__ __forceinline__ int crow(int r, int hh) { return (r & 3) + 8 * (r >> 2) + 4 * hh; }
__device__ __forceinline__ bool attn_tile_ok(int i, int qb) { if (i < 4) return true; const int ks = qb * 64 - 128 + 64 * (i - 4); return ks >= 0 && ks < SEQ; }
__device__ __forceinline__ void attn_issue(const bf16* Z, const bf16* VT, int i, int b, int kvh, int qb, int tid, v4u (&kreg)[2], v4u (&vreg)[2]) {
    const bf16* kbase; const bf16* vbase; int tl;
    if (i < 4) { kbase = Z + (size_t)(ML + b * CTXL + 64 * i) * EIN + 1024 + kvh * 128; vbase = VT + (size_t)ML * 256 + (size_t)(b * 2 + kvh) * 128 * CTXL + 64 * i; tl = CTXL; }
    else { const int ks = qb * 64 - 128 + 64 * (i - 4); kbase = Z + (size_t)(b * SEQ + ks) * EIN + 1024 + kvh * 128; vbase = VT + (size_t)(b * 2 + kvh) * 128 * SEQ + ks; tl = SEQ; }
#pragma unroll
    for (int e = 0; e < 2; ++e) { const int id = tid + 512 * e;
        kreg[e] = *(const GAS v4u*)(kbase + (size_t)(id >> 4) * EIN + (id & 15) * 8);
        vreg[e] = *(const GAS v4u*)(vbase + (size_t)(id >> 3) * tl + (id & 7) * 8); }
}
__device__ __forceinline__ void attn_phase(Frame& F) {
    const bf16* Z = WSP(const bf16, WS_Z); const bf16* VT = WSP(const bf16, WS_VT); bf16* AO = WSP(bf16, WS_AO);
    const float* sinks = F.in[8];
    LAS unsigned char* KL = F.lds; LAS unsigned char* VL = F.lds + 17408;
    const int r = F.lane & 31, hh = F.lane >> 5, g = F.wave >> 1, qs = (F.wave & 1) * 32;
    constexpr float CSC = 0.08838834764831845f * 1.4426950408889634f;
    for (int u = F.vcu; u < 528; u += F.G) {
        const bool isc = u >= 512; int b, kvh, qb;
        if (!isc) { b = u >> 8; kvh = (u >> 7) & 1; qb = u & 127; } else { const int v = u - 512; b = v >> 3; kvh = (v >> 2) & 1; qb = v & 3; }
        const int qrow0 = isc ? ML + b * CTXL + qb * 64 : b * SEQ + qb * 64, head = kvh * 4 + g;
        bf16x8 qf[8];
        { const bf16* qp = Z + (size_t)(qrow0 + qs + r) * EIN + head * 128 + 8 * hh;
#pragma unroll
          for (int s = 0; s < 8; ++s) qf[s] = *(const GAS bf16x8*)(qp + 16 * s); }
        const float tsink = sinks[head] * 1.4426950408889634f;
        float m = tsink, l = 0.f;
        f32x16 o[4];
#pragma unroll
        for (int dg = 0; dg < 4; ++dg)
#pragma unroll
            for (int i = 0; i < 16; ++i) o[dg][i] = 0.f;
        const int ntile = isc ? 4 : 9;
        v4u kreg[2][2], vreg[2][2];
        int tcur = 0, tnxt = 1; while (tnxt < ntile && !attn_tile_ok(tnxt, qb)) ++tnxt;
        attn_issue(Z, VT, tcur, b, kvh, qb, F.tid, kreg[0], vreg[0]);
        if (tnxt < ntile) attn_issue(Z, VT, tnxt, b, kvh, qb, F.tid, kreg[1], vreg[1]);
        bool more = true;
        while (more) {
#pragma unroll
          for (int hs = 0; hs < 2; ++hs) { if (more) {
            const int cur = tcur;
            LDS_BARRIER();
#pragma unroll
            for (int e = 0; e < 2; ++e) { const int id = F.tid + 512 * e;
                *(LAS v4u*)(KL + (id >> 4) * 272 + (id & 15) * 16) = kreg[hs][e];
                LAS v2u* vp = (LAS v2u*)(VL + (id >> 3) * 136 + (id & 7) * 16); v2u lo, hi; lo.x = vreg[hs][e].x; lo.y = vreg[hs][e].y; hi.x = vreg[hs][e].z; hi.y = vreg[hs][e].w; vp[0] = lo; vp[1] = hi; }
            LDS_BARRIER();
            int t2 = tnxt + 1; while (t2 < ntile && !attn_tile_ok(t2, qb)) ++t2;
            if (tnxt < ntile && t2 < ntile) attn_issue(Z, VT, t2, b, kvh, qb, F.tid, kreg[hs], vreg[hs]);
            f32x16 sc[2];
#pragma unroll
            for (int kg = 0; kg < 2; ++kg) {
#pragma unroll
                for (int i = 0; i < 16; ++i) sc[kg][i] = 0.f;
#pragma unroll
                for (int s = 0; s < 8; ++s) { const bf16x8 kf = *(const LAS bf16x8*)(KL + (32 * kg + r) * 272 + (16 * s + 8 * hh) * 2);
                    sc[kg] = __builtin_amdgcn_mfma_f32_32x32x16_bf16(kf, qf[s], sc[kg], 0, 0, 0); } }
            const int mode = (cur == 4) ? 1 : (cur == 8 ? 2 : 0);
            float tmax = -3.0e38f;
#pragma unroll
            for (int kg = 0; kg < 2; ++kg)
#pragma unroll
                for (int i = 0; i < 16; ++i) { float t = sc[kg][i] * CSC; const int kk = 32 * kg + crow(i, hh), qq = qs + r;
                    if ((mode == 1 && kk < qq) || (mode == 2 && kk > qq)) t = -1.0e30f;
                    sc[kg][i] = t; tmax = fmaxf(tmax, t); }
            tmax = fmaxf(tmax, __shfl_xor(tmax, 32));
            const float mn = fmaxf(m, tmax), alpha = __builtin_amdgcn_exp2f(m - mn); m = mn;
            float ps = 0.f;
#pragma unroll
            for (int kg = 0; kg < 2; ++kg)
#pragma unroll
                for (int i = 0; i < 16; ++i) { const float p = __builtin_amdgcn_exp2f(sc[kg][i] - m); sc[kg][i] = p; ps += p; }
            l = l * alpha + ps;
#pragma unroll
            for (int dg = 0; dg < 4; ++dg)
#pragma unroll
                for (int i = 0; i < 16; ++i) o[dg][i] *= alpha;
#pragma unroll
            for (int kg = 0; kg < 2; ++kg)
#pragma unroll
                for (int s2 = 0; s2 < 2; ++s2) { v4u pw; pw.x = pk2(sc[kg][8 * s2 + 0], sc[kg][8 * s2 + 1]); pw.y = pk2(sc[kg][8 * s2 + 2], sc[kg][8 * s2 + 3]);
                    pw.z = pk2(sc[kg][8 * s2 + 4], sc[kg][8 * s2 + 5]); pw.w = pk2(sc[kg][8 * s2 + 6], sc[kg][8 * s2 + 7]);
                    const bf16x8 pf = __builtin_bit_cast(bf16x8, pw);
#pragma unroll
                    for (int dg = 0; dg < 4; ++dg) { const LAS unsigned char* vb = VL + (32 * dg + r) * 136 + (32 * kg + 16 * s2 + 4 * hh) * 2;
                        const v2u lo = *(const LAS v2u*)vb, hi = *(const LAS v2u*)(vb + 16); v4u vw; vw.x = lo.x; vw.y = lo.y; vw.z = hi.x; vw.w = hi.y;
                        o[dg] = __builtin_amdgcn_mfma_f32_32x32x16_bf16(__builtin_bit_cast(bf16x8, vw), pf, o[dg], 0, 0, 0); } }
            more = tnxt < ntile; tcur = tnxt; tnxt = t2;
          } }
        }
        const float lt = l + __shfl_xor(l, 32) + __builtin_amdgcn_exp2f(tsink - m), inv = 1.0f / lt;
        bf16* op = AO + (size_t)(qrow0 + qs + r) * DM + head * 128;
#pragma unroll
        for (int dg = 0; dg < 4; ++dg)
#pragma unroll
            for (int g4 = 0; g4 < 4; ++g4) { v2u w; w.x = pk2(o[dg][4 * g4 + 0] * inv, o[dg][4 * g4 + 1] * inv); w.y = pk2(o[dg][4 * g4 + 2] * inv, o[dg][4 * g4 + 3] * inv);
                *(GAS v2u*)(op + 32 * dg + 8 * g4 + 4 * hh) = w; }
    }
}
template <bool FINAL, int z> __device__ __forceinline__ void rglru_blocks(LAS unsigned char* XCB, LAS float* XCF, LAS float* HS, const bf16x8 (&wa)[8], const bf16x8 (&wx)[8],
        float ba, float bxx, float sp8, int r, int hh, int chl, float& st, float& CA, float& CB) {
#pragma unroll
        for (int bi = 0; bi < 2; ++bi) { const int tb = z ? 1 - bi : bi;
            if (z == 1 && bi == 0) __builtin_amdgcn_s_sleep(8);
            f32x16 ya, yx;
#pragma unroll
            for (int i = 0; i < 16; ++i) { ya[i] = ba; yx[i] = bxx; }
#pragma unroll
            for (int s = 0; s < 8; ++s) { const bf16x8 af = *(const LAS bf16x8*)(XCB + (32 * tb + r) * 272 + (16 * s + 8 * hh) * 2);
                ya = __builtin_amdgcn_mfma_f32_32x32x16_bf16(af, wa[s], ya, 0, 0, 0); yx = __builtin_amdgcn_mfma_f32_32x32x16_bf16(af, wx[s], yx, 0, 0, 0); }
            float av[16], bv[16];
#pragma unroll
            for (int i = 0; i < 16; i += 2) {
                typedef float f2 __attribute__((ext_vector_type(2)));
                const f2 xc = {XCF[(32 * tb + crow(i, hh)) * 128 + chl], XCF[(32 * tb + crow(i + 1, hh)) * 128 + chl]};
                const f2 ta = (f2){ya[i], ya[i + 1]} * -1.4426950408889634f, tx = (f2){yx[i], yx[i + 1]} * -1.4426950408889634f;
                f2 ea, ex; ea.x = __builtin_amdgcn_exp2f(ta.x); ea.y = __builtin_amdgcn_exp2f(ta.y); ex.x = __builtin_amdgcn_exp2f(tx.x); ex.y = __builtin_amdgcn_exp2f(tx.y);
                const f2 da = ea + 1.0f, dx = ex + 1.0f;
                f2 rg, ig; rg.x = __builtin_amdgcn_rcpf(da.x); rg.y = __builtin_amdgcn_rcpf(da.y); ig.x = __builtin_amdgcn_rcpf(dx.x); ig.y = __builtin_amdgcn_rcpf(dx.y);
                const f2 la = rg * sp8; f2 a; a.x = __builtin_amdgcn_exp2f(la.x); a.y = __builtin_amdgcn_exp2f(la.y);
                const f2 om = a * -a + 1.0f; f2 sq; sq.x = __builtin_amdgcn_sqrtf(om.x); sq.y = __builtin_amdgcn_sqrtf(om.y);
                const f2 b = sq * ig * xc;
                av[i] = a.x; av[i + 1] = a.y; bv[i] = b.x; bv[i + 1] = b.y; }
            float Ag[4], Bg[4], Ap[4], Bp[4];
#pragma unroll
            for (int g = 0; g < 4; ++g) { float A = 1.f, B = 0.f;
#pragma unroll
                for (int k = 0; k < 4; ++k) { const int kk = z ? 3 - k : k; B = B * av[4 * g + kk] + bv[4 * g + kk]; A *= av[4 * g + kk]; }
                Ag[g] = A; Bg[g] = B; Ap[g] = __shfl_xor(A, 32); Bp[g] = __shfl_xor(B, 32); }
            float ent[4]; float cur = st;
#pragma unroll
            for (int gi = 0; gi < 4; ++gi) { const int g = z ? 3 - gi : gi;
                const bool own_first = z ? (hh == 1) : (hh == 0);
                if (own_first) { ent[g] = cur; cur = Ag[g] * cur + Bg[g]; CB = Ag[g] * CB + Bg[g]; CA *= Ag[g]; cur = Ap[g] * cur + Bp[g]; CB = Ap[g] * CB + Bp[g]; CA *= Ap[g]; }
                else { cur = Ap[g] * cur + Bp[g]; CB = Ap[g] * CB + Bp[g]; CA *= Ap[g]; ent[g] = cur; cur = Ag[g] * cur + Bg[g]; CB = Ag[g] * CB + Bg[g]; CA *= Ag[g]; } }
            st = cur;
            if (FINAL) {
#pragma unroll
                for (int g = 0; g < 4; ++g) { float hc = ent[g];
#pragma unroll
                    for (int k = 0; k < 4; ++k) { const int kk = z ? 3 - k : k; hc = av[4 * g + kk] * hc + bv[4 * g + kk];
                        HS[(z * 64 + 32 * tb + 8 * g + 4 * hh + kk) * 128 + chl] = hc; } } }
        }
}
template <bool FINAL> __device__ __forceinline__ void rglru_pass(Frame& F) {
    const bf16* Z1 = WSP(const bf16, WS_Z); const bf16* WGT = WSP(const bf16, WS_WGT); bf16* AO = WSP(bf16, WS_AO);
    float* SUM = WSP(float, WS_SUM);
    const float* cw = F.in[20]; const float* cb = F.in[21];
    LAS unsigned char* XCB = F.lds;
    LAS float* XCF = (LAS float*)(F.lds + 17408);
    LAS float* HS = (LAS float*)(F.lds + 17408 + 32768);
    const int bx = blockIdx.x, h = bx & 15, cg = bx >> 4, ncg = F.G >> 4;
    if (cg >= ncg) return;
    const int r = F.lane & 31, hh = F.lane >> 5, jg = F.wave & 3, z = F.wave >> 2;
    const int chl = 32 * jg + r, ch = h * 128 + chl;
    bf16x8 wa[8], wx[8];
    { const bf16* pa = WGT + ((size_t)((z * 2 + 0) * 16 + h) * 128 + chl) * 128 + 8 * hh; const bf16* px = WGT + ((size_t)((z * 2 + 1) * 16 + h) * 128 + chl) * 128 + 8 * hh;
#pragma unroll
      for (int s = 0; s < 8; ++s) { wa[s] = *(const GAS bf16x8*)(pa + 16 * s); wx[s] = *(const GAS bf16x8*)(px + 16 * s); } }
    const float ba = F.in[23][z * DM + ch], bxx = F.in[25][z * DM + ch];
    const float sp8 = -8.0f * 1.4426950408889634f * log1pf(__expf(-F.in[26][z * DM + ch]));
    const int nch = FINAL ? 256 : NCHUNK;
    LAS float* CWL = (LAS float*)(F.lds + 17408 + 32768 + 65536);
    __syncthreads();
    for (int i = F.tid; i < 640; i += 512) CWL[i] = i < 512 ? cw[(i >> 7) * DM + h * 128 + (i & 127)] : cb[h * 128 + (i - 512)];
    __syncthreads();
    LAS float* CL = (LAS float*)(F.lds + 17408 + 32768 + 65536 + 2560);
    if (FINAL) { const int b = F.tid >> 8, zz = (F.tid >> 7) & 1, cl = F.tid & 127; const float* sb = SUM + ((size_t)zz * DM + h * 128 + cl) * 2;
        float s = 0.f;
#pragma unroll
        for (int i = 0; i < 4; ++i) { const int c = 256 + b * 4 + (zz ? 3 - i : i); const float2 ab = *(const float2*)(sb + (size_t)c * 4 * DM); s = ab.x * s + ab.y; }
#pragma unroll 8
        for (int i = 0; i < 128; ++i) { const int c = b * 128 + (zz ? 127 - i : i); const float2 ab = *(const float2*)(sb + (size_t)c * 4 * DM);
            const int d = c - cg; if (d >= 0 && d % ncg == 0) CL[(d / ncg) * 256 + zz * 128 + cl] = s;
            s = ab.x * s + ab.y; }
        __syncthreads(); }
    v4u xq[2][4];
#define RG_LOAD_ROWS(cc) do { const int _row0 = (cc) < 256 ? (cc) * 64 : ML + ((cc) - 256) * 64; \
        const int _s0 = (cc) < 256 ? ((cc) >> 7) * SEQ : ML + (((cc) - 256) >> 2) * CTXL, _s1 = _s0 + ((cc) < 256 ? SEQ : CTXL); \
        _Pragma("unroll") for (int it = 0; it < 2; ++it) { const int id = F.tid + 512 * it, row = _row0 + (id >> 4), gc = h * 128 + (id & 15) * 8; \
            _Pragma("unroll") for (int tap = 0; tap < 4; ++tap) { const int rr = row + tap - 2; v4u x = {0u, 0u, 0u, 0u}; \
                if (rr >= _s0 && rr < _s1) x = *(const GAS v4u*)(Z1 + (size_t)rr * 4096 + 2048 + gc); xq[it][tap] = x; } } } while (0)
    if (cg < nch) RG_LOAD_ROWS(cg);
    for (int c = cg; c < nch; c += ncg) {
        const int row0 = c < 256 ? c * 64 : ML + (c - 256) * 64;
        LDS_BARRIER();
#pragma unroll
        for (int it = 0; it < 2; ++it) { const int id = F.tid + 512 * it, t = id >> 4, c8 = (id & 15) * 8;
            float a[8];
            { const f32x4 b0 = *(const LAS f32x4*)(CWL + 512 + c8), b1 = *(const LAS f32x4*)(CWL + 512 + c8 + 4);
              a[0] = b0.x; a[1] = b0.y; a[2] = b0.z; a[3] = b0.w; a[4] = b1.x; a[5] = b1.y; a[6] = b1.z; a[7] = b1.w; }
#pragma unroll
            for (int tap = 0; tap < 4; ++tap) { const v4u x = xq[it][tap];
                const f32x4 w0 = *(const LAS f32x4*)(CWL + tap * 128 + c8), w1 = *(const LAS f32x4*)(CWL + tap * 128 + c8 + 4);
                a[0] += w0.x * bflo(x[0]); a[1] += w0.y * bfhi(x[0]); a[2] += w0.z * bflo(x[1]); a[3] += w0.w * bfhi(x[1]);
                a[4] += w1.x * bflo(x[2]); a[5] += w1.y * bfhi(x[2]); a[6] += w1.z * bflo(x[3]); a[7] += w1.w * bfhi(x[3]); }
            *(LAS f32x4*)(XCF + t * 128 + c8) = (f32x4){a[0], a[1], a[2], a[3]}; *(LAS f32x4*)(XCF + t * 128 + c8 + 4) = (f32x4){a[4], a[5], a[6], a[7]};
            v4u w; w.x = pk2(a[0], a[1]); w.y = pk2(a[2], a[3]); w.z = pk2(a[4], a[5]); w.w = pk2(a[6], a[7]);
            *(LAS v4u*)(XCB + t * 272 + c8 * 2) = w; }
        LDS_BARRIER();
        if (c + ncg < nch) RG_LOAD_ROWS(c + ncg);
        v4u gq[2];
        if (FINAL) {
#pragma unroll
            for (int it = 0; it < 2; ++it) { const int id = F.tid + 512 * it; gq[it] = *(const GAS v4u*)(Z1 + (size_t)(row0 + (id >> 4)) * 4096 + h * 128 + (id & 15) * 8); } }
        float st = 0.f, CA = 1.f, CB = 0.f;
        if (FINAL) st = CL[((c - cg) / ncg) * 256 + z * 128 + chl];
        if (z == 0) rglru_blocks<FINAL, 0>(XCB, XCF, HS, wa, wx, ba, bxx, sp8, r, hh, chl, st, CA, CB);
        else rglru_blocks<FINAL, 1>(XCB, XCF, HS, wa, wx, ba, bxx, sp8, r, hh, chl, st, CA, CB);
        if (!FINAL) { if (hh == 0) { float* sp = SUM + (((size_t)c * 2 + z) * DM + ch) * 2; sp[0] = CA; sp[1] = CB; } }
        else {
            LDS_BARRIER();
#pragma unroll
            for (int it = 0; it < 2; ++it) { const int id = F.tid + 512 * it, t = id >> 4, c8 = (id & 15) * 8, row = row0 + t, gc = h * 128 + c8;
                const f32x4 f0 = *(const LAS f32x4*)(HS + t * 128 + c8), f1 = *(const LAS f32x4*)(HS + t * 128 + c8 + 4);
                const f32x4 b0 = *(const LAS f32x4*)(HS + (64 + t) * 128 + c8), b1 = *(const LAS f32x4*)(HS + (64 + t) * 128 + c8 + 4);
                const v4u gt = gq[it];
                v4u w; w.x = pk2((f0.x + b0.x) * bflo(gt.x), (f0.y + b0.y) * bfhi(gt.x)); w.y = pk2((f0.z + b0.z) * bflo(gt.y), (f0.w + b0.w) * bfhi(gt.y));
                w.z = pk2((f1.x + b1.x) * bflo(gt.z), (f1.y + b1.y) * bfhi(gt.z)); w.w = pk2((f1.z + b1.z) * bflo(gt.w), (f1.w + b1.w) * bfhi(gt.w));
                *(GAS v4u*)(AO + (size_t)row * DM + gc) = w; }
        }
    }
#undef RG_LOAD_ROWS
}
__device__ __forceinline__ void route_phase(Frame& F) {
    const float* g = F.in[28]; const float* mod = WSP(const float, WS_MOD1); const float* rw = F.in[29]; const float* rb = F.in[30];
    bf16* XN = WSP(bf16, WS_XN);
    int* tok_e = WSP(int, WS_ROUTE); int* tok_rank = tok_e + 2 * ML; float* tok_w = (float*)(tok_rank + 2 * ML);
    LAS int* lcnt = (LAS int*)(F.lds); LAS int* lbase = lcnt + 8;
    LAS int* lrow = lcnt + 16;
    LAS f32x4* rwl = (LAS f32x4*)(F.lds + 2048);
    __syncthreads();
    for (int s4 = F.tid; s4 < 4096; s4 += 512) { const int k = s4 >> 1, half = s4 & 1, j = k >> 8, ln = (k >> 2) & 63, q = k & 3;
        rwl[((j * 4 + q) * 2 + half) * 64 + ln] = *(const GAS f32x4*)(rw + (size_t)k * 8 + 4 * half); }
    __syncthreads();
    for (int base = F.vcu * 64; base < ML; base += F.G * 64) {
        __syncthreads();
        if (F.tid < 8) lcnt[F.tid] = 0;
        __syncthreads();
        for (int i = 0; i < 8; ++i) { const int row = base + F.wave * 8 + i;
            const float* mv = mod + (size_t)(row >> 13) * MOD_W;
            const GAS v2u* xr = (const GAS v2u*)(WSP(const bf16, WS_H) + (size_t)row * DM) + F.lane;
            f32x4 v[8]; float s = 0.f;
#pragma unroll
            for (int j = 0; j < 8; ++j) { const v2u w = xr[64 * j]; v[j].x = bflo(w.x); v[j].y = bfhi(w.x); v[j].z = bflo(w.y); v[j].w = bfhi(w.y); s += (v[j].x * v[j].x + v[j].y * v[j].y) + (v[j].z * v[j].z + v[j].w * v[j].w); }
            const float rstd = 1.0f / sqrtf(wave_sum(s) * (1.0f / DM) + NORM_EPS);
            GAS unsigned* o4 = (GAS unsigned*)((unsigned char*)XN + (size_t)row * DM) + F.lane;
            float lg[8];
#pragma unroll
            for (int e = 0; e < 8; ++e) lg[e] = 0.f;
#pragma unroll
            for (int j = 0; j < 8; ++j) { const int col = 4 * (F.lane + 64 * j);
                const f32x4 gg = *(const GAS f32x4*)(g + col), sh = *(const GAS f32x4*)(mv + 3 * DM + col), sc = *(const GAS f32x4*)(mv + 4 * DM + col);
                const f32x4 y = v[j] * rstd * gg * (sc + 1.0f) + sh; o4[64 * j] = pk4_fp8(clamp8(y.x), clamp8(y.y), clamp8(y.z), clamp8(y.w));
#pragma unroll
                for (int q = 0; q < 4; ++q) { const f32x4 w0 = rwl[((j * 4 + q) * 2 + 0) * 64 + F.lane], w1 = rwl[((j * 4 + q) * 2 + 1) * 64 + F.lane];
                    lg[0] += y[q] * w0.x; lg[1] += y[q] * w0.y; lg[2] += y[q] * w0.z; lg[3] += y[q] * w0.w; lg[4] += y[q] * w1.x; lg[5] += y[q] * w1.y; lg[6] += y[q] * w1.z; lg[7] += y[q] * w1.w; } }
#pragma unroll
            for (int e = 0; e < 8; ++e) lg[e] = wave_sum(lg[e]) + rb[e];
            int e0 = 0; float l0 = lg[0];
#pragma unroll
            for (int e = 1; e < 8; ++e) if (lg[e] > l0) { l0 = lg[e]; e0 = e; }
            int e1 = -1; float l1 = -3.0e38f;
#pragma unroll
            for (int e = 0; e < 8; ++e) if (e != e0 && lg[e] > l1) { l1 = lg[e]; e1 = e; }
            if (F.lane == 0) { const float w1 = 1.0f / (1.0f + __expf(l0 - l1)); const int r0 = atomicAdd((int*)&lcnt[e0], 1), r1 = atomicAdd((int*)&lcnt[e1], 1);
                LAS int* pr = lrow + (F.wave * 8 + i) * 4; pr[0] = e0; pr[1] = r0; pr[2] = e1; pr[3] = r1;
                tok_e[2 * row] = e0; tok_e[2 * row + 1] = e1; tok_w[2 * row] = 1.0f - w1; tok_w[2 * row + 1] = w1; }
        }
        __syncthreads();
        if (F.tid < 8) lbase[F.tid] = (int)__hip_atomic_fetch_add((unsigned*)(F.ctl + CW_CNT + F.tid), (unsigned)lcnt[F.tid], RLX_AGENT);
        __syncthreads();
        if (F.tid < 64) { const int row = base + F.tid; const LAS int* pr = lrow + F.tid * 4; tok_rank[2 * row] = lbase[pr[0]] + pr[1]; tok_rank[2 * row + 1] = lbase[pr[2]] + pr[3]; }
        VM_WAIT();
        { unsigned char* XGS = F.ws + WS_XGS;
#pragma unroll
          for (int i = 0; i < 8; ++i) { const int row = base + F.wave * 8 + i; const LAS int* pr = lrow + (F.wave * 8 + i) * 4;
              const v4u* src = (const v4u*)((const unsigned char*)XN + (size_t)row * DM) + F.lane;
              const v4u x0 = __builtin_nontemporal_load((const GAS v4u*)src), x1 = __builtin_nontemporal_load((const GAS v4u*)(src + 64));
#pragma unroll
              for (int sl = 0; sl < 2; ++sl) { const int e = pr[2 * sl], rk = lbase[e] + pr[2 * sl + 1];
                  GAS v4u* dst = (GAS v4u*)(XGS + ((size_t)e * ML + rk) * DM) + F.lane; dst[0] = x0; dst[64] = x1; } } }
    }
}
__device__ __forceinline__ void gather_phase(Frame& F) {
    const bf16* XN = WSP(const bf16, WS_XN); bf16* XG = WSP(bf16, WS_Z);
    const int* tok_e = WSP(const int, WS_ROUTE); const int* tok_rank = tok_e + 2 * ML;
    int off[8]; { int t = 0;
#pragma unroll
        for (int e = 0; e < 8; ++e) { off[e] = t; t += ((__builtin_amdgcn_readfirstlane((int)F.ctl[CW_CNT + e]) + 255) >> 8) << 8; } }
    const int gw = F.vcu * NWAVES + F.wave, NGW = F.G * NWAVES;
    for (int a = gw; a < 2 * ML; a += NGW) { const int row = a >> 1, e = tok_e[a], rk = tok_rank[a]; int o = 0;
#pragma unroll
        for (int k = 0; k < 8; ++k) o = (e == k) ? off[k] : o;
        const GAS v4u* src = (const GAS v4u*)((const unsigned char*)XN + (size_t)row * DM) + F.lane; GAS v4u* dst = (GAS v4u*)((unsigned char*)XG + (size_t)(o + rk) * DM) + F.lane;
#pragma unroll
        for (int j = 0; j < 2; ++j) dst[64 * j] = src[64 * j]; }
}
__device__ __forceinline__ f32x4 y2_load(Frame& F, const bf16* Y2, size_t s, int col) {
    f32x4 r;
    if (s < (size_t)Y2_FULL_TILES * 256 * DM) { const v2u y = *(const GAS v2u*)(Y2 + s + col); r.x = bflo(y.x); r.y = bfhi(y.x); r.z = bflo(y.y); r.w = bfhi(y.y); }
    else { const bf16* P = WSP(const bf16, WS_XN) + (s - (size_t)Y2_FULL_TILES * 256 * DM) + col; r = (f32x4){0.f, 0.f, 0.f, 0.f};
#pragma unroll
        for (int p = 0; p < 7; ++p) { const v2u y = *(const GAS v2u*)(P + (size_t)p * Y2_PART_ROWS * DM); r.x += bflo(y.x); r.y += bfhi(y.x); r.z += bflo(y.y); r.w += bfhi(y.y); } }
    return r;
}
__device__ __forceinline__ void final_phase(Frame& F) {
    const bf16* Y2 = WSP(const bf16, WS_Z); const float* mod = WSP(const float, WS_MOD1); const float* fg = F.in[34];
    const int* tok_e = WSP(const int, WS_ROUTE); const int* tok_rank = tok_e + 2 * ML; const float* tok_w = (const float*)(tok_rank + 2 * ML);
    int off[8]; { int t = 0;
#pragma unroll
        for (int e = 0; e < 8; ++e) { off[e] = t; t += ((__builtin_amdgcn_readfirstlane((int)F.ctl[CW_CNT + e]) + 255) >> 8) << 8; } }
    const int gw = F.vcu * NWAVES + F.wave, NGW = F.G * NWAVES;
    for (int row = gw; row < ML; row += NGW) {
        const int e0 = tok_e[2 * row], e1 = tok_e[2 * row + 1]; int o0 = 0, o1 = 0;
#pragma unroll
        for (int k = 0; k < 8; ++k) { o0 = (e0 == k) ? off[k] : o0; o1 = (e1 == k) ? off[k] : o1; }
        const size_t s0 = (size_t)(o0 + tok_rank[2 * row]) * DM, s1 = (size_t)(o1 + tok_rank[2 * row + 1]) * DM; const float w0 = tok_w[2 * row], w1 = tok_w[2 * row + 1];
        const float* g2 = mod + (size_t)(row >> 13) * MOD_W + 5 * DM;
        GAS f32x4* xr = (GAS f32x4*)(F.out + (size_t)row * DM) + F.lane;
        const GAS v2u* hr = (const GAS v2u*)(WSP(const bf16, WS_H) + (size_t)row * DM) + F.lane;
        f32x4 v[8]; float s = 0.f;
        const bool tail = __builtin_amdgcn_readfirstlane((int)((s0 >= (size_t)Y2_FULL_TILES * 256 * DM) | (s1 >= (size_t)Y2_FULL_TILES * 256 * DM))) != 0;
        if (!tail) {
#pragma unroll
            for (int j = 0; j < 8; ++j) { const int col = 4 * (F.lane + 64 * j);
                const v2u ya = *(const GAS v2u*)(Y2 + s0 + col), yb = *(const GAS v2u*)(Y2 + s1 + col); const f32x4 gg = *(const GAS f32x4*)(g2 + col);
                f32x4 mo; mo.x = w0 * bflo(ya.x) + w1 * bflo(yb.x); mo.y = w0 * bfhi(ya.x) + w1 * bfhi(yb.x); mo.z = w0 * bflo(ya.y) + w1 * bflo(yb.y); mo.w = w0 * bfhi(ya.y) + w1 * bfhi(yb.y);
                { const v2u hw = hr[64 * j]; f32x4 hv; hv.x = bflo(hw.x); hv.y = bfhi(hw.x); hv.z = bflo(hw.y); hv.w = bfhi(hw.y); v[j] = hv + gg * mo; } s += (v[j].x * v[j].x + v[j].y * v[j].y) + (v[j].z * v[j].z + v[j].w * v[j].w); }
        } else {
#pragma unroll
            for (int j = 0; j < 8; ++j) { const int col = 4 * (F.lane + 64 * j);
                const f32x4 fa = y2_load(F, Y2, s0, col), fb = y2_load(F, Y2, s1, col); const f32x4 gg = *(const GAS f32x4*)(g2 + col);
                const f32x4 mo = w0 * fa + w1 * fb;
                { const v2u hw = hr[64 * j]; f32x4 hv; hv.x = bflo(hw.x); hv.y = bfhi(hw.x); hv.z = bflo(hw.y); hv.w = bfhi(hw.y); v[j] = hv + gg * mo; } s += (v[j].x * v[j].x + v[j].y * v[j].y) + (v[j].z * v[j].z + v[j].w * v[j].w); }
        }
        const float rstd = 1.0f / sqrtf(wave_sum(s) * (1.0f / DM) + NORM_EPS);
#pragma unroll
        for (int j = 0; j < 8; ++j) { const int col = 4 * (F.lane + 64 * j); xr[64 * j] = v[j] * rstd * *(const GAS f32x4*)(fg + col); }
    }
}
constexpr int N_PHASES = 20;
#ifndef MK_ONE_LAUNCH
#define MK_ONE_LAUNCH 1
#endif
__global__ void __launch_bounds__(NWAVES * 64, 2) fwd_kernel(Args args) {
    extern __shared__ __attribute__((aligned(16))) unsigned char lds_raw[];
    Frame F;
    F.lds = (LAS unsigned char*)lds_raw;
    F.tid = threadIdx.x; F.lane = F.tid & 63; F.wave = __builtin_amdgcn_readfirstlane(F.tid >> 6);
    F.G = gridDim.x; { const int bx = blockIdx.x; F.vcu = (F.G % 8 == 0) ? (bx % 8) * (F.G / 8) + bx / 8 : bx; }
    F.in = args.in; F.out = args.out; F.ws = args.ws; F.ctl = (gu32*)(args.ws + WS_CTL);
    volatile LAS unsigned* MISC = (volatile LAS unsigned*)(F.lds + MISC_OFF);
    for (int u = F.tid; u < (LDS_BYTES - MISC_OFF) / 4; u += NWAVES * 64) MISC[u] = 0u;
    __syncthreads();
    const int lo = args.ph_lo, hi = args.ph_hi;
    XcdBarrier bar = xcd_barrier_post((unsigned*)(F.ctl + CW_BAR), MISC + 8, (unsigned)gridDim.x);
#ifdef ONLY_PH
#define IN(k) ((k) == ONLY_PH)
#else
#define IN(k) (lo <= (k) && (k) < hi)
#endif
#ifndef MK_NCV7
#define MK_NCV7 56
#endif
#ifndef MK_NCV8
#define MK_NCV8 80
#endif
#ifndef MK_TAIL_MASK
#define MK_TAIL_MASK ((1u << 7) | (1u << 8))
#endif
#define SEAM(k) do { if (IN(k) && IN((k) + 1)) { if ((MK_TAIL_MASK >> (k)) & 1u) moe_pull(F, (k), 0); if ((k) == 9) moe_pull(F, -1, NQ_LATE); if ((k) == 15) moe_pull(F, -1, NQ); xcd_barrier(bar); { int t_ = threadIdx.x; asm volatile("" : "+v"(t_)); F.tid = t_; F.lane = t_ & 63; } } } while (0)
    const pg8::bf16_t* XN = WSP(const pg8::bf16_t, WS_XN);

    if (IN(0)) { p0_prologue(F); } SEAM(0);
    if (IN(1)) { norm_phase<false>(F, F.in[0], F.in[2], F.in[6], WSP(const float, WS_MOD0), 0, DM, MT); } SEAM(1);
    if (IN(2)) { pg8::Gemm g{XN, WSP(const pg8::bf16_t, WS_WIN0), MT, EIN, DM, 0, DM, 0, 0}; pg8::StaticOrder S; S.init(MT, EIN, F.G, (int)blockIdx.x);
        pg8::EpiBf16 E{WSP(pg8::bf16_t, WS_Z), EIN, 0, 0, 1.0f};
        pg8::gemm_phase<pg8::EpiBf16, pg8::StaticOrder, true, true>(F.lds, g, S, E); } SEAM(2);
    if (IN(3)) { rope_conv_phase(F); } SEAM(3);
    if (IN(4)) { attn_phase(F); } SEAM(4);
    if (IN(5)) { pg8::Gemm g{WSP(const pg8::bf16_t, WS_AO), WSP(const pg8::bf16_t, WS_WOUT0), MT, DM, DM, 0, DM, 0, 0}; pg8::StaticOrder S; S.init(MT, DM, F.G, (int)blockIdx.x);
        pg8::EpiResH<false> E{F.in[0], F.in[2], WSP(pg8::bf16_t, WS_H), WSP(const float, WS_MOD0) + 2 * DM, 1.0f};
        pg8::gemm_phase<pg8::EpiResH<false>, pg8::StaticOrder, true, true>(F.lds, g, S, E); } SEAM(5);
    if (IN(6)) { norm_phase<FFN8 != 0, true>(F, nullptr, nullptr, F.in[12], WSP(const float, WS_MOD0), 3 * DM, 4 * DM, MT); } SEAM(6);
    const int GWK7 = F.G >= 2 * MK_NCV7 ? F.G - MK_NCV7 : F.G, GWK8 = F.G >= 2 * MK_NCV8 ? F.G - MK_NCV8 : F.G;
    if (IN(7) && (int)blockIdx.x < GWK7) { pg8::Gemm g{XN, WSP(const pg8::bf16_t, WS_WGU0), MT, 2 * DFF, FFN8 ? DM / 2 : DM, 0, FFN8 ? DM / 2 : DM, 0, 0}; pg8::StaticOrder S; S.init(MT, 2 * DFF, GWK7, (int)blockIdx.x);
        if constexpr (FFN8) { pg8::EpiSwiGLU8 E{WSP(unsigned char, WS_HID), DFF, 4.0f, 1.0f / 64.0f}; pg8::gemm_phase<pg8::EpiSwiGLU8, pg8::StaticOrder, true, true, true>(F.lds, g, S, E); }
        else { pg8::EpiSwiGLU E{WSP(pg8::bf16_t, WS_HID), DFF}; pg8::gemm_phase<pg8::EpiSwiGLU, pg8::StaticOrder, true, true>(F.lds, g, S, E); } } SEAM(7);
    if (IN(8) && (int)blockIdx.x < GWK8) { pg8::Gemm g{WSP(const pg8::bf16_t, WS_HID), WSP(const pg8::bf16_t, WS_WD0), MT, DM, FFN8 ? DFF / 2 : DFF, 0, FFN8 ? DFF / 2 : DFF, 0, 0}; pg8::StaticOrder S; S.init(MT, DM, GWK8, (int)blockIdx.x);
        pg8::EpiResH<true> E{nullptr, nullptr, WSP(pg8::bf16_t, WS_H), WSP(const float, WS_MOD0) + 5 * DM, FFN8 ? 1.0f / 256.0f : 1.0f};
        pg8::gemm_phase<pg8::EpiResH<true>, pg8::StaticOrder, true, true, FFN8 != 0>(F.lds, g, S, E); } SEAM(8);
    if (IN(9)) { norm_phase<false, true>(F, nullptr, nullptr, F.in[18], WSP(const float, WS_MOD1), 0, DM, MT); } SEAM(9);
    if (IN(10)) { pg8::Gemm g{XN, WSP(const pg8::bf16_t, WS_WIN1), MT, 2 * DM, DM, 0, DM, 0, 0}; pg8::StaticOrder S; S.init(MT, 2 * DM, F.G, (int)blockIdx.x);
        pg8::EpiBf16 E{WSP(pg8::bf16_t, WS_Z), 2 * DM, 8, 0, 1.0f};
        pg8::gemm_phase<pg8::EpiBf16, pg8::StaticOrder, true, true>(F.lds, g, S, E); } SEAM(10);
    if (IN(11)) { rglru_pass<false>(F); } SEAM(11);
    if (IN(13)) { rglru_pass<true>(F); } SEAM(13);
    if (IN(14)) { pg8::Gemm g{WSP(const pg8::bf16_t, WS_AO), WSP(const pg8::bf16_t, WS_WOUT1), ML, DM, DM, 0, DM, 0, 0}; pg8::StaticOrder S; S.init(ML, DM, F.G, (int)blockIdx.x);
        pg8::EpiResH<true> E{nullptr, nullptr, WSP(pg8::bf16_t, WS_H), WSP(const float, WS_MOD1) + 2 * DM, 1.0f};
        pg8::gemm_phase<pg8::EpiResH<true>, pg8::StaticOrder, true, true>(F.lds, g, S, E); } SEAM(14);
    if (IN(15)) { route_phase(F); } SEAM(15);
    if (IN(17)) { pg8::Gemm g{WSP(const pg8::bf16_t, WS_XGS), WSP(const pg8::bf16_t, WS_MWGU), CAP, 2 * DFFE, DM / 2, (size_t)2 * DFFE * DM, DM / 2, 0x79797979, 0x7F7F7F7F}; pg8::MoeOrder S; S.init((const int*)(F.ctl + CW_CNT), 2 * DFFE, 1, F.G, (int)blockIdx.x); S.atile = ML / 256;
        pg8::EpiSwiGLU8 E{WSP(unsigned char, WS_HID), DFFE, 4.0f, 1.0f / 64.0f};
        pg8::gemm_phase<pg8::EpiSwiGLU8, pg8::MoeOrder, true, false, true>(F.lds, g, S, E); } SEAM(17);
    if (IN(18)) { pg8::Gemm g{WSP(const pg8::bf16_t, WS_HID), WSP(const pg8::bf16_t, WS_MWD), CAP, DM, DFFE / 2, (size_t)DM * DFFE, DFFE / 2, 0x79797979, 0x7D7D7D7D}; pg8::MoeOrder S; S.init((const int*)(F.ctl + CW_CNT), DM, 1, F.G, (int)blockIdx.x, 0, Y2_FULL_TILES);
        pg8::EpiBf16 E{WSP(pg8::bf16_t, WS_Z), DM, 0, 0, 1.0f / (64.0f * 4.0f)};
        pg8::gemm_phase<pg8::EpiBf16, pg8::MoeOrder, true, true, true>(F.lds, g, S, E);
        pg8::Gemm g2{WSP(const pg8::bf16_t, WS_HID), WSP(const pg8::bf16_t, WS_MWD), CAP, DM, DFFE / 2, (size_t)DM * DFFE, DFFE / 14, 0x79797979, 0x7D7D7D7D}; pg8::MoeOrder S2; S2.init((const int*)(F.ctl + CW_CNT), DM, 7, F.G, (int)blockIdx.x, Y2_FULL_TILES);
        pg8::EpiBf16 E2{WSP(pg8::bf16_t, WS_XN) - (size_t)Y2_FULL_TILES * 256 * DM, DM, 0, (size_t)Y2_PART_ROWS * DM, 1.0f / (64.0f * 4.0f)};
        pg8::gemm_phase<pg8::EpiBf16, pg8::MoeOrder, true, true, true>(F.lds, g2, S2, E2); } SEAM(18);
    if (IN(19)) { final_phase(F); }
#undef IN
#undef SEAM
#undef SEAM_A
}

extern "C" void kernel_launch(void* const* d_in, const int* in_sizes, int n_in, void* d_out, int out_size, void* d_ws, size_t ws_size, hipStream_t stream) {
    static int grid = 0;
    if (grid == 0) {
        if (n_in != 35 || out_size != ML * DM || ws_size < WS_END) { fprintf(stderr, "kernel_launch: unexpected shapes (n_in %d out %d ws %zu need %zu)\n", n_in, out_size, ws_size, (size_t)WS_END); grid = -1; return; }
        int dev = 0, cus = 0, per_cu = 0;
        if (hipGetDevice(&dev) != hipSuccess || hipDeviceGetAttribute(&cus, hipDeviceAttributeMultiprocessorCount, dev) != hipSuccess) { grid = -1; return; }
        if (hipFuncSetAttribute((const void*)fwd_kernel, hipFuncAttributeMaxDynamicSharedMemorySize, LDS_BYTES) != hipSuccess) { fprintf(stderr, "kernel_launch: hipFuncSetAttribute failed\n"); grid = -1; return; }
        if (hipOccupancyMaxActiveBlocksPerMultiprocessor(&per_cu, (const void*)fwd_kernel, NWAVES * 64, LDS_BYTES) != hipSuccess || per_cu < 1) { fprintf(stderr, "kernel_launch: occupancy query says %d\n", per_cu); }
        (void)hipGetLastError();
        grid = cus;
    }
    if (grid < 0) return;
    (void)hipMemsetAsync((char*)d_ws + WS_CTL, 0, CTL_ZERO_BYTES, stream);
    Args a{};
    for (int i = 0; i < 35; ++i) a.in[i] = (const float*)d_in[i];
    a.out = (float*)d_out; a.ws = (unsigned char*)d_ws;
#if MK_ONE_LAUNCH
    a.ph_lo = 0; a.ph_hi = N_PHASES;
    hipLaunchKernelGGL(fwd_kernel, dim3(grid), dim3(NWAVES * 64), LDS_BYTES, stream, a);
#else
    for (int p = 0; p < N_PHASES; ++p) { a.ph_lo = p; a.ph_hi = p + 1;
        hipLaunchKernelGGL(fwd_kernel, dim3(grid), dim3(NWAVES * 64), LDS_BYTES, stream, a); }
#endif
}
```

```cpp
#include <hip/hip_runtime.h>
#include <cstdio>
#include <cstdint>
namespace pg8 {
#define PG8_LAS __attribute__((address_space(3)))
typedef unsigned short bf16_t;
typedef short bf16x8 __attribute__((ext_vector_type(8)));
typedef float f32x4 __attribute__((ext_vector_type(4)));
typedef unsigned u32x4 __attribute__((ext_vector_type(4)));
typedef int i32x4 __attribute__((ext_vector_type(4)));
typedef int i32x8 __attribute__((ext_vector_type(8)));
constexpr int BM = 256, BK = 64, HALF = 128, HTB = HALF * BK * 2  , STAGE_BYTES = 8 * HTB, NXCD = 8, WGM = 8;

__host__ __device__ __forceinline__ int lds_byte(int r, int c) { const int st = (r >> 4) * 2 + (c >> 5), rr = r & 15, cc = c & 31, ob = rr * 64 + cc * 2; return st * 1024 + (ob ^ (((ob >> 9) & 1) << 5)); }
__host__ __device__ __forceinline__ void stage_rc(int b, int& R, int& C) { const int st = b / 1024, sb = b % 1024, swz = sb ^ (((sb >> 9) & 1) << 5); R = (st >> 1) * 16 + swz / 64; C = (st & 1) * 32 + (swz % 64) / 2; }
__host__ __device__ __forceinline__ int perm32(int rho) { const int n = rho >> 4, i = rho & 15; return 8 * (i >> 2) + 4 * n + (i & 3); }

struct Unit { int pm, pn, be, ks, pa; };
struct Gemm { const bf16_t* A; const bf16_t* Bt; int M, N, K; size_t bstride; int KL; int sw, sa; };

#ifndef MK_STATIC_ORD2
#define MK_STATIC_ORD2 1
#endif
struct StaticOrder {
    int nM, nN, nwg, G, c;
    __host__ __device__ void init(int M, int N, int G_, int c_) { nM = M / BM; nN = N / BM; nwg = nM * nN; G = G_; c = c_; }
    __host__ __device__ bool next(int i, Unit& u) const {
        const long L = (long)i * G + c; if (L >= nwg) return false;
#if MK_STATIC_ORD2
        { const int FULL = 32 * nN, nfull = nM >> 5, remm = nM & 31, l = (int)L;
          if (l < nfull * FULL) { const int sg = l / FULL, r = l - sg * FULL, nb = r >> 8, q = r & 255, x = q & 7, j = q >> 3; u.pm = 32 * sg + 4 * x + (j & 3); u.pn = 8 * nb + (j >> 2); }
          else { const int r = l - nfull * FULL, vq = r / remm; u.pm = 32 * nfull + (r - vq * remm); u.pn = vq; } }
        u.be = 0; u.ks = 0; u.pa = u.pm; return true;
#else
        int wgid = (int)L; { const int q = nwg / NXCD, r = nwg % NXCD, xcd = wgid % NXCD, off = wgid / NXCD; wgid = (xcd < r ? xcd * (q + 1) : r * (q + 1) + (xcd - r) * q) + off; }
        const int nig = WGM * nN, gid = wgid / nig, fm = gid * WGM, gsz = (nM - fm) < WGM ? (nM - fm) : WGM;
        u.pm = fm + ((wgid % nig) % gsz); u.pn = (wgid % nig) / gsz; u.be = 0; u.ks = 0; u.pa = u.pm; return true;
#endif
    }
    __device__ __forceinline__ void a_ready(const Unit&) const {}
    __device__ __forceinline__ void done(const Unit&) const {}
};

__device__ __forceinline__ unsigned cvt_pk_bf16(float lo, float hi) { unsigned r; asm volatile("v_cvt_pk_bf16_f32 %0, %1, %2" : "=v"(r) : "v"(lo), "v"(hi)); return r; }
__device__ __forceinline__ float fast_sigmoid(float x) { return __builtin_amdgcn_rcpf(1.0f + __builtin_amdgcn_exp2f(-1.4426950408889634f * x)); }
__device__ __forceinline__ float gelu_tanh(float x) { const float y = x + 0.044715f * x * x * x; return x * __builtin_amdgcn_rcpf(1.0f + __builtin_amdgcn_exp2f(-2.302208198f * y)); }

struct EpiBf16 {
    static constexpr bool PERM = true, AFTER_DRAIN = false;
    bf16_t* O; int ldc; int nact; size_t ks_stride; float ascale;
    __device__ __forceinline__ void operator()(const f32x4 (&acc)[2][2][4][2], const Unit& u, int wr, int wc, int fr, int fq) const {
        const int row0 = u.pm * BM + wr * 64 + fr, col0 = u.pn * BM + wc * 32 + 8 * fq; const bool act = u.pn < nact;
#pragma unroll
        for (int ai = 0; ai < 2; ++ai)
#pragma unroll
            for (int m = 0; m < 4; ++m) { bf16_t* rowp = O + (size_t)u.ks * ks_stride + (size_t)(row0 + ai * HALF + m * 16) * ldc + col0;
#pragma unroll
                for (int bj = 0; bj < 2; ++bj) { f32x4 v0 = acc[ai][bj][m][0] * ascale, v1 = acc[ai][bj][m][1] * ascale;
                    if (act) {
#pragma unroll
                        for (int j = 0; j < 4; ++j) { v0[j] = gelu_tanh(v0[j]); v1[j] = gelu_tanh(v1[j]); } }
                    u32x4 w; w.x = cvt_pk_bf16(v0[0], v0[1]); w.y = cvt_pk_bf16(v0[2], v0[3]); w.z = cvt_pk_bf16(v1[0], v1[1]); w.w = cvt_pk_bf16(v1[2], v1[3]);
                    *(u32x4*)(rowp + bj * HALF) = w; } }
    }
};
struct EpiSwiGLU {
    static constexpr bool PERM = true, AFTER_DRAIN = false;
    bf16_t* O; int ldc;
    __device__ __forceinline__ void operator()(const f32x4 (&acc)[2][2][4][2], const Unit& u, int wr, int wc, int fr, int fq) const {
        const int row0 = u.pm * BM + wr * 64 + fr, col0 = u.pn * HALF + wc * 32 + 8 * fq;
#pragma unroll
        for (int ai = 0; ai < 2; ++ai)
#pragma unroll
            for (int m = 0; m < 4; ++m) { bf16_t* rowp = O + (size_t)(row0 + ai * HALF + m * 16) * ldc + col0;
                f32x4 h0, h1;
#pragma unroll
                for (int j = 0; j < 4; ++j) { const float g0 = acc[ai][0][m][0][j], g1 = acc[ai][0][m][1][j];
                    h0[j] = g0 * fast_sigmoid(g0) * acc[ai][1][m][0][j]; h1[j] = g1 * fast_sigmoid(g1) * acc[ai][1][m][1][j]; }
                u32x4 w; w.x = cvt_pk_bf16(h0[0], h0[1]); w.y = cvt_pk_bf16(h0[2], h0[3]); w.z = cvt_pk_bf16(h1[0], h1[1]); w.w = cvt_pk_bf16(h1[2], h1[3]);
                *(u32x4*)rowp = w; }
    }
};
struct EpiSwiGLU8 {
    static constexpr bool PERM = true, AFTER_DRAIN = false;
    unsigned char* O; int ldc; float scale, ascale;
    typedef float f2 __attribute__((ext_vector_type(2)));
    __device__ __forceinline__ f2 swi2(f2 G, f2 U, float kexp, float kout) const {
        const f2 t = G * kexp; f2 e; e.x = __builtin_amdgcn_exp2f(t.x); e.y = __builtin_amdgcn_exp2f(t.y);
        const f2 d = e + 1.0f; f2 r; r.x = __builtin_amdgcn_rcpf(d.x); r.y = __builtin_amdgcn_rcpf(d.y);
        f2 h = (G * U) * r * kout; h.x = __builtin_amdgcn_fmed3f(h.x, -448.f, 448.f); h.y = __builtin_amdgcn_fmed3f(h.y, -448.f, 448.f); return h; }
    __device__ __forceinline__ void operator()(const f32x4 (&acc)[2][2][4][2], const Unit& u, int wr, int wc, int fr, int fq) const {
        const int row0 = u.pm * BM + wr * 64 + fr, col0 = u.pn * HALF + wc * 32 + 8 * fq;
        const float kexp = -1.4426950408889634f * ascale, kout = ascale * ascale * scale;
#pragma unroll
        for (int ai = 0; ai < 2; ++ai)
#pragma unroll
            for (int m = 0; m < 4; ++m) { unsigned char* rowp = O + (size_t)(row0 + ai * HALF + m * 16) * ldc + col0;
                const f32x4 g0 = acc[ai][0][m][0], g1 = acc[ai][0][m][1], u0 = acc[ai][1][m][0], u1 = acc[ai][1][m][1];
                const f2 a = swi2((f2){g0[0], g0[1]}, (f2){u0[0], u0[1]}, kexp, kout), b = swi2((f2){g0[2], g0[3]}, (f2){u0[2], u0[3]}, kexp, kout);
                const f2 c = swi2((f2){g1[0], g1[1]}, (f2){u1[0], u1[1]}, kexp, kout), d = swi2((f2){g1[2], g1[3]}, (f2){u1[2], u1[3]}, kexp, kout);
                int p0 = 0, p1 = 0;
                p0 = __builtin_amdgcn_cvt_pk_fp8_f32(a.x, a.y, p0, false); p0 = __builtin_amdgcn_cvt_pk_fp8_f32(b.x, b.y, p0, true);
                p1 = __builtin_amdgcn_cvt_pk_fp8_f32(c.x, c.y, p1, false); p1 = __builtin_amdgcn_cvt_pk_fp8_f32(d.x, d.y, p1, true);
                typedef unsigned u32x2 __attribute__((ext_vector_type(2))); u32x2 w; w.x = (unsigned)p0; w.y = (unsigned)p1; *(u32x2*)rowp = w; }
    }
};
struct EpiRes {
    static constexpr bool PERM = false, AFTER_DRAIN = false;
    const float* resL; const float* resC; float* outL; float* outC; const float* gate; int ldc; float ascale;
    __device__ __forceinline__ void operator()(const f32x4 (&acc)[2][2][4][2], const Unit& u, int wr, int wc, int fr, int fq) const {
        const bool isc = u.pm >= 64; const int pml = isc ? u.pm - 64 : u.pm; const int v = isc ? 2 : (u.pm >> 5);
        const float* res = isc ? resC : resL; float* out = isc ? outC : outL; const float* gv = gate + (size_t)v * 12288;
        const int row0 = pml * BM + wr * 64 + fr, col0 = u.pn * BM + wc * 32 + 4 * fq;
        f32x4 gg[2][2];
#pragma unroll
        for (int bj = 0; bj < 2; ++bj)
#pragma unroll
            for (int n = 0; n < 2; ++n) gg[bj][n] = *(const f32x4*)(gv + col0 + bj * HALF + n * 16) * ascale;
#pragma unroll
        for (int ai = 0; ai < 2; ++ai) {
            f32x4 bs[4][2][2];
#pragma unroll
            for (int m = 0; m < 4; ++m) { const size_t off = (size_t)(row0 + ai * HALF + m * 16) * ldc + col0;
#pragma unroll
                for (int bj = 0; bj < 2; ++bj)
#pragma unroll
                    for (int n = 0; n < 2; ++n) bs[m][bj][n] = *(const f32x4*)(res + off + bj * HALF + n * 16); }
#pragma unroll
            for (int m = 0; m < 4; ++m) { const size_t off = (size_t)(row0 + ai * HALF + m * 16) * ldc + col0;
#pragma unroll
                for (int bj = 0; bj < 2; ++bj)
#pragma unroll
                    for (int n = 0; n < 2; ++n) *(f32x4*)(out + off + bj * HALF + n * 16) = bs[m][bj][n] + gg[bj][n] * acc[ai][bj][m][n]; }
            asm volatile("" ::: "memory"); }
    }
};
template <bool RB> struct EpiResH {
    static constexpr bool PERM = true, AFTER_DRAIN = false;
    const float* resL; const float* resC; bf16_t* H; const float* gate; float ascale;
    __device__ __forceinline__ void operator()(const f32x4 (&acc)[2][2][4][2], const Unit& u, int wr, int wc, int fr, int fq) const {
        const bool isc = u.pm >= 64; const int v = isc ? 2 : (u.pm >> 5);
        const float* gv = gate + (size_t)v * 12288;
        const int row0 = u.pm * BM + wr * 64 + fr, col0 = u.pn * BM + wc * 32 + 8 * fq;
        f32x4 gg[2][2];
#pragma unroll
        for (int bj = 0; bj < 2; ++bj)
#pragma unroll
            for (int n = 0; n < 2; ++n) gg[bj][n] = *(const f32x4*)(gv + col0 + bj * HALF + n * 4) * ascale;
#pragma unroll
        for (int ai = 0; ai < 2; ++ai) {
            if constexpr (RB) {
                u32x4 bs[4][2];
#pragma unroll
                for (int m = 0; m < 4; ++m)
#pragma unroll
                    for (int bj = 0; bj < 2; ++bj) bs[m][bj] = *(const u32x4*)(H + (size_t)(row0 + ai * HALF + m * 16) * 2048 + col0 + bj * HALF);
#pragma unroll
                for (int m = 0; m < 4; ++m)
#pragma unroll
                    for (int bj = 0; bj < 2; ++bj) { const u32x4 b = bs[m][bj];
                        f32x4 r0, r1; r0.x = __builtin_bit_cast(float, b.x << 16); r0.y = __builtin_bit_cast(float, b.x & 0xffff0000u); r0.z = __builtin_bit_cast(float, b.y << 16); r0.w = __builtin_bit_cast(float, b.y & 0xffff0000u);
                        r1.x = __builtin_bit_cast(float, b.z << 16); r1.y = __builtin_bit_cast(float, b.z & 0xffff0000u); r1.z = __builtin_bit_cast(float, b.w << 16); r1.w = __builtin_bit_cast(float, b.w & 0xffff0000u);
                        r0 += gg[bj][0] * acc[ai][bj][m][0]; r1 += gg[bj][1] * acc[ai][bj][m][1];
                        u32x4 w; w.x = cvt_pk_bf16(r0[0], r0[1]); w.y = cvt_pk_bf16(r0[2], r0[3]); w.z = cvt_pk_bf16(r1[0], r1[1]); w.w = cvt_pk_bf16(r1[2], r1[3]);
                        *(u32x4*)(H + (size_t)(row0 + ai * HALF + m * 16) * 2048 + col0 + bj * HALF) = w; }
            } else {
                const float* res = isc ? resC - (size_t)16384 * 2048 : resL;
                f32x4 bs[4][2][2];
#pragma unroll
                for (int m = 0; m < 4; ++m)
#pragma unroll
                    for (int bj = 0; bj < 2; ++bj)
#pragma unroll
                        for (int n = 0; n < 2; ++n) bs[m][bj][n] = *(const f32x4*)(res + (size_t)(row0 + ai * HALF + m * 16) * 2048 + col0 + bj * HALF + n * 4);
#pragma unroll
                for (int m = 0; m < 4; ++m)
#pragma unroll
                    for (int bj = 0; bj < 2; ++bj) { const f32x4 r0 = bs[m][bj][0] + gg[bj][0] * acc[ai][bj][m][0], r1 = bs[m][bj][1] + gg[bj][1] * acc[ai][bj][m][1];
                        u32x4 w; w.x = cvt_pk_bf16(r0[0], r0[1]); w.y = cvt_pk_bf16(r0[2], r0[3]); w.z = cvt_pk_bf16(r1[0], r1[1]); w.w = cvt_pk_bf16(r1[2], r1[3]);
                        *(u32x4*)(H + (size_t)(row0 + ai * HALF + m * 16) * 2048 + col0 + bj * HALF) = w; }
            }
            asm volatile("" ::: "memory"); }
    }
};
struct MoeOrder {
    int nM, nN, nwg, G, c, nNr, pm0, atile; int toff[9];
    __device__ __forceinline__ void init(const int* counts, int N, int nsplit, int G_, int c_, int pm_lo = 0, int pm_hi = 1 << 20) { int t = 0;
#pragma unroll
        for (int e = 0; e < 8; ++e) { toff[e] = t; t += (__builtin_amdgcn_readfirstlane(counts[e]) + 255) >> 8; }
        toff[8] = t; atile = 0; const int hi = t < pm_hi ? t : pm_hi; pm0 = pm_lo; nM = hi > pm_lo ? hi - pm_lo : 0; nNr = N / BM; nN = nNr * nsplit; nwg = nM * nN; G = G_; c = c_; }
    __device__ __forceinline__ bool next(int i, Unit& u) const {
        const long L = (long)i * G + c; if (L >= nwg) return false;
        int pml, v;
        if ((nN & 7) == 0) {
            const int FULL = 32 * nN, nfull = nM >> 5, remm = nM & 31, l = (int)L;
            if (l < nfull * FULL) { const int sg = l / FULL, r = l - sg * FULL, nb = r >> 8, q = r & 255, x = q & 7, j = q >> 3;
                pml = 32 * sg + 4 * x + (j & 3); v = 8 * nb + (j >> 2); }
            else { const int r = l - nfull * FULL, x = r & 7, j = r >> 3, jq = j / remm;
                pml = 32 * nfull + (j - jq * remm); v = x + 8 * jq; }
        } else {
            int wgid = (int)L; { const int q = nwg / NXCD, r = nwg % NXCD, xcd = wgid % NXCD, off = wgid / NXCD; wgid = (xcd < r ? xcd * (q + 1) : r * (q + 1) + (xcd - r) * q) + off; }
            const int nig = WGM * nN, gid = wgid / nig, fm = gid * WGM, gsz = (nM - fm) < WGM ? (nM - fm) : WGM;
            pml = fm + ((wgid % nig) % gsz); v = (wgid % nig) / gsz; }
        u.pm = pm0 + pml; u.ks = v / nNr; u.pn = v - u.ks * nNr; int e = 0;
#pragma unroll
        for (int k = 1; k < 8; ++k) e += (u.pm >= toff[k]) ? 1 : 0;
        int tb = 0;
#pragma unroll
        for (int k = 1; k < 8; ++k) tb = (u.pm >= toff[k]) ? toff[k] : tb;
        u.be = e; u.pa = atile > 0 ? e * atile + (u.pm - tb) : u.pm; return true;
    }
    __device__ __forceinline__ void a_ready(const Unit&) const {}
    __device__ __forceinline__ void done(const Unit&) const {}
};

template <class Epi, class Sched, bool ALIGN_EPI = false, bool SP2 = false, bool FP8 = false>
__device__ __forceinline__ void gemm_phase(PG8_LAS unsigned char* lds, const Gemm g, const Sched& S, const Epi& E) {
    int tid_ = threadIdx.x; asm volatile("" : "+v"(tid_));
    const int tid = tid_, wid = __builtin_amdgcn_readfirstlane(tid >> 6), lane = tid & 63, wr = wid >> 2, wc = wid & 3, fr = lane & 15, fq = lane >> 4;
    const int K = g.K, nt = g.KL / BK; const size_t kspl = (size_t)g.KL * 2;
    unsigned voffA[2], voffB[2];
#pragma unroll
    for (int i = 0; i < 2; ++i) { int R, C; stage_rc(tid * 16 + i * 8192, R, C); const int Rb = Epi::PERM ? ((R & ~31) + perm32(R & 31)) : R;
        voffA[i] = (unsigned)(R * K + C) * 2u; voffB[i] = (unsigned)(Rb * K + C) * 2u; }
    const size_t kstep = (size_t)(BK * 2);
    const size_t hstep = (size_t)HALF * K * 2;
    const size_t tstep = 2 * hstep;
    const unsigned ldsw = (unsigned)wid * 1024u;
    const int aoff = lds_byte(wr * 64 + fr, fq * 8), boff = lds_byte(wc * 32 + fr, fq * 8);
#define PG8_SA(b, h) (((b) * 2 + (h)) * HTB)
#define PG8_SB(b, h) ((4 + (b) * 2 + (h)) * HTB)
#define PG8_STAGE(bufoff, gbase, voff) do { _Pragma("unroll") for (int _i = 0; _i < 2; ++_i) \
        __builtin_amdgcn_global_load_lds((const unsigned*)((const char*)(gbase) + (voff)[_i]), (PG8_LAS unsigned*)(lds + (bufoff) + ldsw + _i * 8192), 16, 0, 0); } while (0)
#define PG8_LDA(dst, b, h) do { if constexpr (FP8) { _Pragma("unroll") for (int m = 0; m < 4; ++m) { dst##8[m].lo = *(const PG8_LAS i32x4*)(lds + PG8_SA(b, h) + aoff + m * 2048); dst##8[m].hi = *(const PG8_LAS i32x4*)(lds + PG8_SA(b, h) + aoff + m * 2048 + 1024); } } \
        else { _Pragma("unroll") for (int m = 0; m < 4; ++m) _Pragma("unroll") for (int k = 0; k < 2; ++k) dst[m][k] = *(const PG8_LAS bf16x8*)(lds + PG8_SA(b, h) + aoff + m * 2048 + k * 1024); } } while (0)
#define PG8_LDB(dst, b, h) do { if constexpr (FP8) { _Pragma("unroll") for (int n = 0; n < 2; ++n) { dst##8[n].lo = *(const PG8_LAS i32x4*)(lds + PG8_SB(b, h) + boff + n * 2048); dst##8[n].hi = *(const PG8_LAS i32x4*)(lds + PG8_SB(b, h) + boff + n * 2048 + 1024); } } \
        else { _Pragma("unroll") for (int n = 0; n < 2; ++n) _Pragma("unroll") for (int k = 0; k < 2; ++k) dst[n][k] = *(const PG8_LAS bf16x8*)(lds + PG8_SB(b, h) + boff + n * 2048 + k * 1024); } } while (0)
#define PG8_MMA(ai, bj, At, Bt) do { __builtin_amdgcn_s_setprio(1); _Pragma("unroll") for (int m = 0; m < 4; ++m) _Pragma("unroll") for (int n = 0; n < 2; ++n) { \
        if constexpr (FP8) { asm volatile("v_mfma_f32_16x16x128_f8f6f4 %0, %1, %2, %0" : "+v"(acc[ai][bj][m][n]) : "v"(Bt##8[n]), "v"(At##8[m])); }     \
        else { _Pragma("unroll") for (int k = 0; k < 2; ++k) acc[ai][bj][m][n] = __builtin_amdgcn_mfma_f32_16x16x32_bf16(Bt[n][k], At[m][k], acc[ai][bj][m][n], 0, 0, 0); } } __builtin_amdgcn_s_setprio(0); } while (0)
#define PG8_WAIT_V(n) asm volatile("s_waitcnt vmcnt(" #n ")" ::: "memory")
#define PG8_WAIT_L(n) asm volatile("s_waitcnt lgkmcnt(" #n ")" ::: "memory")
#define PG8_BAR __builtin_amdgcn_s_barrier()
#define PG8_SCHED __builtin_amdgcn_sched_barrier(0)
    Unit cur, nxt; int ui = 0;
    if (!S.next(0, cur)) return;
    f32x4 acc[2][2][4][2];
#pragma unroll
    for (int a = 0; a < 2; ++a)
#pragma unroll
        for (int b = 0; b < 2; ++b)
#pragma unroll
            for (int m = 0; m < 4; ++m)
#pragma unroll
                for (int n = 0; n < 2; ++n) acc[a][b][m][n] = (f32x4){0.f, 0.f, 0.f, 0.f};
    bf16x8 At[4][2], B0[2][2], B1[2][2];
    i32x8 At8[4], B08[2], B18[2];
    const char* cA = (const char*)g.A + (size_t)cur.pa * tstep + (size_t)cur.ks * kspl; const char* cB = (const char*)g.Bt + (size_t)cur.be * g.bstride + (size_t)cur.pn * tstep + (size_t)cur.ks * kspl;
    S.a_ready(cur);
    if constexpr (SP2) {
        PG8_STAGE(PG8_SB(0, 0), cB, voffB); PG8_STAGE(PG8_SB(0, 1), cB + hstep, voffB); PG8_STAGE(PG8_SA(0, 0), cA, voffA); PG8_STAGE(PG8_SA(0, 1), cA + hstep, voffA);
        if (wr == 1) PG8_BAR;
        PG8_WAIT_V(2); PG8_BAR;
        PG8_STAGE(PG8_SB(1, 0), cB + kstep, voffB); PG8_STAGE(PG8_SA(1, 0), cA + kstep, voffA); PG8_STAGE(PG8_SB(1, 1), cB + hstep + kstep, voffB);
        PG8_WAIT_V(6); PG8_BAR;
    } else {
        PG8_STAGE(PG8_SB(0, 0), cB, voffB); PG8_STAGE(PG8_SA(0, 0), cA, voffA); PG8_STAGE(PG8_SB(0, 1), cB + hstep, voffB); PG8_STAGE(PG8_SA(0, 1), cA + hstep, voffA);
        if (wr == 1) PG8_BAR;
        PG8_WAIT_V(4); PG8_BAR;
        PG8_STAGE(PG8_SB(1, 0), cB + kstep, voffB); PG8_STAGE(PG8_SA(1, 0), cA + kstep, voffA); PG8_STAGE(PG8_SB(1, 1), cB + hstep + kstep, voffB);
        PG8_WAIT_V(6); PG8_BAR;
    }
    for (;;) {
        const bool has_next = S.next(ui + 1, nxt);
        const char* nA = has_next ? (const char*)g.A + (size_t)nxt.pa * tstep + (size_t)nxt.ks * kspl : cA; const char* nB = has_next ? (const char*)g.Bt + (size_t)nxt.be * g.bstride + (size_t)nxt.pn * tstep + (size_t)nxt.ks * kspl : cB;
        for (int t = 0; t < nt; t += 2) {
            const bool last = (t == nt - 2);
            const char* a1 = cA + (size_t)(t + 1) * kstep;
            const char* a2 = last ? nA : cA + (size_t)(t + 2) * kstep; const char* b2 = last ? nB : cB + (size_t)(t + 2) * kstep;
            const char* a3 = a2 + kstep; const char* b3 = b2 + kstep;
            if (last && has_next) S.a_ready(nxt);
            if constexpr (SP2) {
            PG8_LDB(B0, 0, 0); PG8_LDB(B1, 0, 1); PG8_SCHED; PG8_LDA(At, 0, 0); PG8_STAGE(PG8_SA(1, 1), a1 + hstep, voffA);
            PG8_WAIT_V(8); PG8_WAIT_L(0); PG8_BAR; PG8_MMA(0, 0, At, B0); PG8_MMA(0, 1, At, B1); PG8_BAR; PG8_SCHED;
            PG8_LDA(At, 0, 1); PG8_STAGE(PG8_SB(0, 0), b2, voffB); PG8_STAGE(PG8_SB(0, 1), b2 + hstep, voffB); PG8_STAGE(PG8_SA(0, 0), a2, voffA);
            PG8_WAIT_V(8); PG8_WAIT_L(0); PG8_BAR; PG8_MMA(1, 0, At, B0); PG8_MMA(1, 1, At, B1); PG8_BAR; PG8_SCHED;
            PG8_LDB(B0, 1, 0); PG8_LDB(B1, 1, 1); PG8_SCHED; PG8_LDA(At, 1, 0); PG8_STAGE(PG8_SA(0, 1), a2 + hstep, voffA);
            PG8_WAIT_V(8); PG8_WAIT_L(0); PG8_BAR; PG8_MMA(0, 0, At, B0); PG8_MMA(0, 1, At, B1); PG8_BAR; PG8_SCHED;
            PG8_LDA(At, 1, 1); PG8_STAGE(PG8_SB(1, 0), b3, voffB); PG8_STAGE(PG8_SB(1, 1), b3 + hstep, voffB); PG8_STAGE(PG8_SA(1, 0), a3, voffA);
            PG8_WAIT_V(8); PG8_WAIT_L(0); PG8_BAR; PG8_MMA(1, 0, At, B0); PG8_MMA(1, 1, At, B1); PG8_BAR; PG8_SCHED;
            } else {
            PG8_LDB(B0, 0, 0); PG8_SCHED; PG8_LDA(At, 0, 0); PG8_STAGE(PG8_SA(1, 1), a1 + hstep, voffA);
            PG8_WAIT_L(8); PG8_BAR; PG8_WAIT_L(0); PG8_MMA(0, 0, At, B0); PG8_BAR; PG8_SCHED;
            PG8_LDB(B1, 0, 1); PG8_STAGE(PG8_SB(0, 0), b2, voffB);
            PG8_BAR; PG8_WAIT_L(0); PG8_MMA(0, 1, At, B1); PG8_BAR;
            PG8_LDA(At, 0, 1); PG8_STAGE(PG8_SA(0, 0), a2, voffA);
            PG8_BAR; PG8_WAIT_L(0); PG8_MMA(1, 0, At, B0); PG8_BAR; PG8_SCHED;
            PG8_STAGE(PG8_SB(0, 1), b2 + hstep, voffB);
            PG8_WAIT_V(6); PG8_BAR; PG8_MMA(1, 1, At, B1); PG8_BAR;
            PG8_LDB(B0, 1, 0); PG8_SCHED; PG8_LDA(At, 1, 0); PG8_STAGE(PG8_SA(0, 1), a2 + hstep, voffA);
            PG8_WAIT_L(8); PG8_BAR; PG8_WAIT_L(0); PG8_MMA(0, 0, At, B0); PG8_BAR; PG8_SCHED;
            PG8_LDB(B1, 1, 1); PG8_STAGE(PG8_SB(1, 0), b3, voffB);
            PG8_BAR; PG8_WAIT_L(0); PG8_MMA(0, 1, At, B1); PG8_BAR;
            PG8_LDA(At, 1, 1); PG8_STAGE(PG8_SA(1, 0), a3, voffA);
            PG8_BAR; PG8_WAIT_L(0); PG8_MMA(1, 0, At, B0); PG8_BAR; PG8_SCHED;
            PG8_STAGE(PG8_SB(1, 1), b3 + hstep, voffB);
            PG8_WAIT_V(6); PG8_BAR; PG8_MMA(1, 1, At, B1); PG8_BAR;
            }
        }
        if constexpr (ALIGN_EPI) { if (wr == 0) PG8_BAR; }
        if constexpr (FP8) { asm volatile("s_nop 15\n\ts_nop 15" ::: "memory"); }
        if constexpr (!Epi::AFTER_DRAIN) { E(acc, cur, wr, wc, fr, fq); S.done(cur); }
        if (!has_next) break;
#pragma unroll
        for (int a = 0; a < 2; ++a)
#pragma unroll
            for (int b = 0; b < 2; ++b)
#pragma unroll
                for (int m = 0; m < 4; ++m)
#pragma unroll
                    for (int n = 0; n < 2; ++n) acc[a][b][m][n] = (f32x4){0.f, 0.f, 0.f, 0.f};
        cur = nxt; cA = nA; cB = nB; ++ui;
        if constexpr (ALIGN_EPI) { if (wr == 1) PG8_BAR; }
    }
    PG8_WAIT_V(0);
    if constexpr (!ALIGN_EPI) { if (wr == 0) PG8_BAR; }
    PG8_BAR;
    if constexpr (Epi::AFTER_DRAIN) { E.fused(acc, cur, wr, wc, fr, fq, lds, wid, lane); S.done(cur); }
#undef PG8_SA
#undef PG8_SB
#undef PG8_STAGE
#undef PG8_LDA
#undef PG8_LDB
#undef PG8_MMA
#undef PG8_WAIT_V
#undef PG8_WAIT_L
#undef PG8_BAR
#undef PG8_SCHED
}
}
constexpr int NWAVES = 8;
constexpr int DM = 2048, SEQ = 8192, NBATCH = 2, CTXL = 256;
constexpr int ML = NBATCH * SEQ, MC = NBATCH * CTXL, MT = ML + MC;
constexpr int EIN = 4608, DFF = 5632, DFFE = 7168, NEXP = 8;
constexpr int MOD_W = 6 * DM;
constexpr int CAP = 2 * ML + NEXP * 256;
constexpr float NORM_EPS = 1e-6f;
constexpr int Y2_FULL_TILES = 128, Y2_PART_ROWS = 8 * 256;
static_assert((size_t)7 * Y2_PART_ROWS * DM * 2 <= (size_t)MT * DM * 2, "the partials fit the XN region");
constexpr int NCHUNK = ML / 64 + MC / 64;

constexpr size_t MiB = 1u << 20;
constexpr size_t al(size_t x) { return (x + MiB - 1) / MiB * MiB; }
constexpr size_t WS_CTL = 0, CTL_ZERO_BYTES = 1 * MiB;
constexpr size_t WS_MOD0 = 1 * MiB;
constexpr size_t WS_MOD1 = WS_MOD0 + 3 * MOD_W * 4;
constexpr size_t WS_ROPE = WS_MOD1 + 3 * MOD_W * 4;
constexpr size_t WS_ROUTE = 2 * MiB;
constexpr size_t WS_SUM = 3 * MiB;
constexpr size_t WS_CARRY = WS_SUM + al((size_t)NCHUNK * 2 * DM * 8);
constexpr size_t WS_HC = WS_CARRY + al((size_t)256 * 2 * DM * 4);
constexpr size_t WS_WIN0 = WS_HC + al((size_t)MC * DM * 4);
constexpr size_t WS_WOUT0 = WS_WIN0 + al((size_t)EIN * DM * 2);
constexpr size_t WS_WGU0 = WS_WOUT0 + al((size_t)DM * DM * 2);
constexpr size_t WS_WD0 = WS_WGU0 + al((size_t)2 * DFF * DM * 2);
constexpr size_t WS_WIN1 = WS_WD0 + al((size_t)DM * DFF * 2);
constexpr size_t WS_WGT = WS_WIN1 + al((size_t)2 * DM * DM * 2);
constexpr size_t WS_WOUT1 = WS_WGT + al((size_t)64 * 128 * 128 * 2);
constexpr size_t WS_MWGU = WS_WOUT1 + al((size_t)DM * DM * 2);
constexpr size_t WS_MWD = WS_MWGU + al((size_t)NEXP * 2 * DFFE * DM);
constexpr size_t WS_XN = WS_MWD + al((size_t)NEXP * DM * DFFE);
constexpr size_t WS_AO = WS_XN + al((size_t)MT * DM * 2);
constexpr size_t WS_VT = WS_AO + al((size_t)MT * DM * 2);
constexpr size_t WS_Z = WS_VT + al((size_t)(ML + MC) * 256 * 2);
constexpr size_t WS_HID = WS_Z + al((size_t)MT * EIN * 2);
constexpr size_t WS_H = WS_HID + al((size_t)CAP * DFFE * 2);
constexpr size_t WS_XGS = WS_H + al((size_t)MT * DM * 2);
constexpr size_t WS_END = WS_XGS + al((size_t)NEXP * ML * DM);
static_assert((size_t)CAP * DM * 2 <= (size_t)MT * EIN * 2, "XG fits the Z region");
static_assert(WS_Z - WS_XN >= (size_t)CAP * DM * 2, "split-K partial buffer 0 fits XN|AO|VT");
constexpr int CW_TMO = 0, CW_CODE = 1;
constexpr int CW_BAR = 4096;
constexpr int CW_BAR2 = 16384;
constexpr int CW_CNT = 8192;
constexpr int CW_QHEAD = 8256;
constexpr int CW_DONE = 8320;
constexpr int CW_W13 = 8320;

constexpr int RING_BYTES = 131072;
constexpr int SCR_BYTES = 151552;
constexpr int MISC_OFF = SCR_BYTES;
constexpr int LDS_BYTES = 155648;

#define GAS __attribute__((address_space(1)))
#define LAS __attribute__((address_space(3)))
typedef unsigned short bf16;
typedef unsigned v4u __attribute__((ext_vector_type(4)));
typedef unsigned v2u __attribute__((ext_vector_type(2)));
typedef float f32x4 __attribute__((ext_vector_type(4)));
typedef float f32x16 __attribute__((ext_vector_type(16)));
typedef short bf16x8 __attribute__((ext_vector_type(8)));
typedef GAS unsigned gu32;
#define RLX_AGENT __ATOMIC_RELAXED, __HIP_MEMORY_SCOPE_AGENT
#define LDS_WAIT() asm volatile("s_waitcnt lgkmcnt(0)" ::: "memory")
#define VM_WAIT() asm volatile("s_waitcnt vmcnt(0)" ::: "memory")
#define LDS_BARRIER() do { asm volatile("s_waitcnt lgkmcnt(0)" ::: "memory"); __builtin_amdgcn_s_barrier(); asm volatile("" ::: "memory"); } while (0)
__device__ __forceinline__ unsigned f2bf(float f) { unsigned u = __builtin_bit_cast(unsigned, f); return (u + 0x7fffu + ((u >> 16) & 1u)) >> 16; }
__device__ __forceinline__ unsigned pk2(float lo, float hi) { return pg8::cvt_pk_bf16(lo, hi); }
__device__ __forceinline__ float bflo(unsigned w) { return __builtin_bit_cast(float, w << 16); }
__device__ __forceinline__ float bfhi(unsigned w) { return __builtin_bit_cast(float, w & 0xffff0000u); }
__device__ __forceinline__ float wave_sum(float v) {
#pragma unroll
    for (int o = 1; o < 64; o <<= 1) v += __shfl_xor(v, o);
    return v;
}

#define XB_TMO      128
#define XB_XCNT(j)  (256  + 64 * (j))
#define XB_XSUB(j)  (1280 + 64 * (j))
#define XB_XGEN(j)  (2304 + 64 * (j))
#define XB_TOP      3328
#define XB_TOPGEN   3392
#define XCD_BAR_WORDS 3456
#define XB_SPIN_CAP (1u << 18)

__device__ __forceinline__ unsigned xb_ld(unsigned* p)              { return __hip_atomic_load(p, __ATOMIC_RELAXED, __HIP_MEMORY_SCOPE_AGENT); }
__device__ __forceinline__ unsigned xb_add(unsigned* p, unsigned v) { return __hip_atomic_fetch_add(p, v, __ATOMIC_RELAXED, __HIP_MEMORY_SCOPE_AGENT); }
__device__ __forceinline__ unsigned xb_xcc_id() { return (unsigned)__builtin_amdgcn_s_getreg((3 << 11) | 20) & 0xFu; }
#define XB_SPIN(cond, bar) do { unsigned _sp = 0; while (cond) { __builtin_amdgcn_s_sleep(1); \
    if ((++_sp & 255u) == 0u) { if (xb_ld(&(bar)[XB_TMO])) break; if (_sp > XB_SPIN_CAP) { atomicAdd(&(bar)[XB_TMO], 1u); break; } } } } while (0)

struct XcdBarrier {
    unsigned* bar; unsigned x; unsigned total;
    volatile LAS unsigned* st;
};

__device__ __forceinline__ XcdBarrier xcd_barrier_post(unsigned* bar, volatile LAS unsigned* st, unsigned total) {
    XcdBarrier b; b.bar = bar; b.x = xb_xcc_id(); b.st = st; b.total = total;
    if (threadIdx.x == 0) (void)xb_add(&bar[XB_XCNT(b.x)], 1u);
    return b;
}
__device__ __forceinline__ void xcd_barrier_complete(unsigned* bar, unsigned x, unsigned G, unsigned& nloc, unsigned& nx) {
    unsigned sum, cnt, mine, sp = 0u;
    for (;;) {
        sum = 0u; cnt = 0u; mine = 0u;
#pragma unroll
        for (unsigned j = 0; j < 16; ++j) { const unsigned c = xb_ld(&bar[XB_XCNT(j)]); sum += c; cnt += (c > 0u) ? 1u : 0u; mine = (j == x) ? c : mine; }
        if (sum == G) break;
        __builtin_amdgcn_s_sleep(1);
        if ((++sp & 255u) == 0u) { if (xb_ld(&bar[XB_TMO])) break; if (sp > XB_SPIN_CAP) { atomicAdd(&bar[XB_TMO], 1u); break; } }
    }
    nloc = mine > 0u ? mine : 1u; nx = cnt > 0u ? cnt : 1u;
}

__device__ __forceinline__ void xcd_barrier(const XcdBarrier& b) {
    asm volatile("s_waitcnt vmcnt(0)" ::: "memory");
    __syncthreads();
    if (threadIdx.x == 0) {
        unsigned* bar = b.bar;
        __builtin_amdgcn_s_waitcnt(0);
        unsigned nloc = b.st[0], nx = b.st[1];
        if (nloc == 0u) { xcd_barrier_complete(bar, b.x, b.total, nloc, nx); b.st[0] = nloc; b.st[1] = nx; }
        const unsigned old = xb_add(&bar[XB_XSUB(b.x)], 1u);
        const unsigned gen = old / nloc;
        if (old + 1u == (gen + 1u) * nloc) {
            __builtin_amdgcn_fence(__ATOMIC_RELEASE, "agent");
            asm volatile("s_waitcnt vmcnt(0)" ::: "memory");
            const unsigned og = xb_add(&bar[XB_TOP], 1u);
            const unsigned tg = og / nx;
            if (og + 1u == (tg + 1u) * nx) xb_add(&bar[XB_TOPGEN], 1u);
            else XB_SPIN(xb_ld(&bar[XB_TOPGEN]) == tg, bar);
            __builtin_amdgcn_fence(__ATOMIC_ACQUIRE, "agent");
            xb_add(&bar[XB_XGEN(b.x)], 1u);
            asm volatile("s_waitcnt vmcnt(0)" ::: "memory");
        } else {
            XB_SPIN(xb_ld(&bar[XB_XGEN(b.x)]) == gen, bar);
            __builtin_amdgcn_fence(__ATOMIC_ACQUIRE, "agent");
            asm volatile("s_waitcnt vmcnt(0)" ::: "memory");
        }
    }
    __syncthreads();
}

struct Args { const float* in[35]; float* out; unsigned char* ws; int ph_lo, ph_hi; };
struct Frame {
    LAS unsigned char* lds;
    gu32* ctl;
    int tid, lane, wave, vcu, G;
    const float* const* in; float* out; unsigned char* ws;
};
#define WSP(T, off) ((T*)(F.ws + (off)))

__device__ __forceinline__ void tr_item(const float* W, int ldw, int k0, int n0, bf16* WT, int ldt, int dst_row0, LAS float* scr, int lane) {
    const int rr = lane >> 4, c4 = (lane & 15) * 4;
    f32x4 v[16];
#pragma unroll
    for (int i = 0; i < 16; ++i) v[i] = *(const GAS f32x4*)(W + (size_t)(k0 + 4 * i + rr) * ldw + n0 + c4);
#pragma unroll
    for (int i = 0; i < 16; ++i) { LAS float* p = scr + (4 * i + rr) * 65 + c4; p[0] = v[i].x; p[1] = v[i].y; p[2] = v[i].z; p[3] = v[i].w; }
    LDS_WAIT(); asm volatile("" ::: "memory");
    const int kc = lane & 7, nn = lane >> 3;
#pragma unroll
    for (int j = 0; j < 8; ++j) { const int n = nn + 8 * j; const LAS float* s = scr + (8 * kc) * 65 + n;
        v4u o; o.x = pk2(s[0 * 65], s[1 * 65]); o.y = pk2(s[2 * 65], s[3 * 65]); o.z = pk2(s[4 * 65], s[5 * 65]); o.w = pk2(s[6 * 65], s[7 * 65]);
        *(GAS v4u*)(WT + (size_t)(dst_row0 + n) * ldt + k0 + 8 * kc) = o; }
    LDS_WAIT(); asm volatile("" ::: "memory");
}
__device__ __forceinline__ void tr_matrix_item(const float* W, int K, int N, bf16* WT, int mode, int item, LAS float* scr, int lane) {
    const int nb = N / 64, kb = item / nb, nbi = item % nb, k0 = kb * 64, n0 = nbi * 64;
    const int dr = mode == 0 ? n0 : (256 * (n0 >> 7) + (n0 & 127) + (mode == 2 ? 128 : 0));
    tr_item(W, N, k0, n0, WT, K, dr, scr, lane);
}
__device__ __forceinline__ float silu_f(float x) { return x / (1.0f + __expf(-x)); }
__device__ __forceinline__ void adaln_item(Frame& F, const float* wmod, const float* bmod, float* mod, int slab) {
    const float* c = F.in[1]; const float* cc = F.in[3];
    const int c4 = F.tid & 31, kg = F.tid >> 5, n0 = slab * 128 + c4 * 4;
    LAS float* sl = (LAS float*)(F.lds + 32768);
    for (int i = F.tid; i < 3 * DM; i += NWAVES * 64) { const float x = i < 2 * DM ? c[i] : cc[i - 2 * DM]; sl[i] = silu_f(x); }
    __syncthreads();
    f32x4 a0 = {0.f, 0.f, 0.f, 0.f}, a1 = a0, a2 = a0;
#pragma unroll 16
    for (int i = 0; i < 128; ++i) { const int k = kg + 16 * i; const f32x4 w = __builtin_nontemporal_load((const GAS f32x4*)(wmod + (size_t)k * MOD_W + n0));
        const float s0 = sl[k], s1 = sl[DM + k], s2 = sl[2 * DM + k]; a0 += w * s0; a1 += w * s1; a2 += w * s2; }
    LAS float* red = (LAS float*)F.lds;
    *(LAS f32x4*)(red + (kg * 3 + 0) * 128 + c4 * 4) = a0; *(LAS f32x4*)(red + (kg * 3 + 1) * 128 + c4 * 4) = a1; *(LAS f32x4*)(red + (kg * 3 + 2) * 128 + c4 * 4) = a2;
    __syncthreads();
    if (F.tid < 384) { const int v = F.tid >> 7, col = F.tid & 127; float s = bmod[slab * 128 + col];
#pragma unroll
        for (int g = 0; g < 16; ++g) s += red[(g * 3 + v) * 128 + col];
        mod[(size_t)v * MOD_W + slab * 128 + col] = s; }
    __syncthreads();
}
constexpr int I_WIN0 = 32 * 72, I_SQ = 32 * 32, I_F = 32 * 88, I_WIN1 = 32 * 64, I_G = 4, I_ME = 32 * 112;
constexpr int NDENSE = I_WIN0 + I_SQ + 3 * I_F + I_WIN1 + I_SQ + 64 * I_G, NITEMS = NDENSE + 24 * I_ME;
#ifndef MK_FFN8
#define MK_FFN8 1
#endif
constexpr int FFN8 = MK_FFN8;
struct CvItem { const float* src; bf16* dst; int ldw, ldt, f8; };
constexpr float W8_SCALE = 64.0f;
__device__ __forceinline__ unsigned pk4_fp8(float a, float b, float c, float d) { int p = 0; p = __builtin_amdgcn_cvt_pk_fp8_f32(a, b, p, false); p = __builtin_amdgcn_cvt_pk_fp8_f32(c, d, p, true); return (unsigned)p; }
__device__ __forceinline__ float clamp8(float x) { return __builtin_fminf(__builtin_fmaxf(x, -448.0f), 448.0f); }
__device__ __forceinline__ CvItem cv_make(const float* W, int K, int N, bf16* WT, int mode, int sub, int f8 = 0) {
    const int nb = N / 32, kb = sub / nb, nbi = sub % nb, k0 = kb * 128, n0 = nbi * 32;
    const int dr = mode == 0 ? n0 : (256 * (n0 >> 7) + (n0 & 127) + (mode == 2 ? 128 : 0));
    CvItem m; m.src = W + (size_t)k0 * N + n0; m.ldw = N; m.f8 = f8;
    if (f8) { m.dst = (bf16*)((unsigned char*)WT + (size_t)dr * K + k0); m.ldt = K; } else { m.dst = WT + (size_t)dr * K + k0; m.ldt = K; }
    return m;
}
__device__ __forceinline__ CvItem cv_item(Frame& F, int it) {
    int r = it;
    if (r < I_WIN0) return cv_make(F.in[7], DM, EIN, WSP(bf16, WS_WIN0), 0, r); r -= I_WIN0;
    if (r < I_SQ) return cv_make(F.in[11], DM, DM, WSP(bf16, WS_WOUT0), 0, r); r -= I_SQ;
    if (r < I_F) return cv_make(F.in[13], DM, DFF, WSP(bf16, WS_WGU0), 1, r, FFN8); r -= I_F;
    if (r < I_F) return cv_make(F.in[14], DM, DFF, WSP(bf16, WS_WGU0), 2, r, FFN8); r -= I_F;
    if (r < I_F) return cv_make(F.in[15], DFF, DM, WSP(bf16, WS_WD0), 0, r, FFN8); r -= I_F;
    if (r < I_WIN1) return cv_make(F.in[19], DM, 2 * DM, WSP(bf16, WS_WIN1), 0, r); r -= I_WIN1;
    if (r < I_SQ) return cv_make(F.in[27], DM, DM, WSP(bf16, WS_WOUT1), 0, r); r -= I_SQ;
    if (r < 64 * I_G) { const int mtx = r >> 2, sub = r & 3, gt = mtx >> 5, zh = mtx & 31, z = zh >> 4, h = zh & 15;
        return cv_make(F.in[gt ? 24 : 22] + (size_t)zh * 16384, 128, 128, WSP(bf16, WS_WGT) + (size_t)((z * 2 + gt) * 16 + h) * 16384, 0, sub); } r -= 64 * I_G;
    const int w = r / (8 * I_ME), rr = r % (8 * I_ME), e = rr / I_ME, sub = rr % I_ME;
    if (w == 0) return cv_make(F.in[31] + (size_t)e * DM * DFFE, DM, DFFE, (bf16*)(F.ws + WS_MWGU + (size_t)e * 2 * DFFE * DM), 1, sub, 1);
    if (w == 1) return cv_make(F.in[32] + (size_t)e * DM * DFFE, DM, DFFE, (bf16*)(F.ws + WS_MWGU + (size_t)e * 2 * DFFE * DM), 2, sub, 1);
    return cv_make(F.in[33] + (size_t)e * DFFE * DM, DFFE, DM, (bf16*)(F.ws + WS_MWD + (size_t)e * DM * DFFE), 0, sub, 1);
}
__device__ __forceinline__ void cv_load(const CvItem& m, int lane, f32x4 (&v)[16]) {
    const int rr = lane >> 3, c4 = (lane & 7) * 4;
#pragma unroll
    for (int i = 0; i < 16; ++i) v[i] = __builtin_nontemporal_load((const GAS f32x4*)(m.src + (size_t)(8 * i + rr) * m.ldw + c4));
}
__device__ __forceinline__ float clamp8s(float x) { return __builtin_amdgcn_fmed3f(x * W8_SCALE, -448.0f, 448.0f); }
__device__ __forceinline__ void cv_finish(const CvItem& m, int lane, const f32x4 (&v)[16], LAS float* scr) {
    const int rr = lane >> 3, c4 = (lane & 7) * 4;
#pragma unroll
    for (int i = 0; i < 16; ++i) *(LAS f32x4*)(scr + (8 * i + rr) * 36 + (c4 ^ (4 * ((i >> 1) & 7)))) = v[i];
    LDS_WAIT(); asm volatile("" ::: "memory");
    const int kc = lane & 7, nn = lane >> 3;
#pragma unroll
    for (int j = 0; j < 4; ++j) { const int n = nn + 8 * j; const LAS float* s = scr + (16 * kc) * 36 + (n ^ (4 * kc));
        float x[16];
#pragma unroll
        for (int q = 0; q < 16; ++q) x[q] = s[q * 36];
        if (m.f8) { v4u o;
            o.x = pk4_fp8(clamp8s(x[0]), clamp8s(x[1]), clamp8s(x[2]), clamp8s(x[3])); o.y = pk4_fp8(clamp8s(x[4]), clamp8s(x[5]), clamp8s(x[6]), clamp8s(x[7]));
            o.z = pk4_fp8(clamp8s(x[8]), clamp8s(x[9]), clamp8s(x[10]), clamp8s(x[11])); o.w = pk4_fp8(clamp8s(x[12]), clamp8s(x[13]), clamp8s(x[14]), clamp8s(x[15]));
            __builtin_nontemporal_store(o, (GAS v4u*)((unsigned char*)m.dst + (size_t)n * m.ldt + 16 * kc)); }
        else { v4u o0, o1; o0.x = pk2(x[0], x[1]); o0.y = pk2(x[2], x[3]); o0.z = pk2(x[4], x[5]); o0.w = pk2(x[6], x[7]); o1.x = pk2(x[8], x[9]); o1.y = pk2(x[10], x[11]); o1.z = pk2(x[12], x[13]); o1.w = pk2(x[14], x[15]);
            GAS v4u* d = (GAS v4u*)(m.dst + (size_t)n * m.ldt + 16 * kc); __builtin_nontemporal_store(o0, d); __builtin_nontemporal_store(o1, d + 1); } }
    LDS_WAIT(); asm volatile("" ::: "memory");
}
constexpr int NEARLY = I_WIN0 + I_SQ + 3 * I_F;
constexpr int NQ = NITEMS - NEARLY, NQ_LATE = I_WIN1 + I_SQ + 64 * I_G;
__device__ __forceinline__ void convert_dense(Frame& F) {
    LAS float* scr = (LAS float*)(F.lds + F.wave * 18432);
    const int NW = F.G * NWAVES; int r = F.vcu * NWAVES + F.wave;
    f32x4 va[16], vb[16]; CvItem ma, mb;
    if (r < NEARLY) { ma = cv_item(F, r); cv_load(ma, F.lane, va); }
#pragma unroll 1
    for (; r < NEARLY; r += 2 * NW) {
        const bool hb = r + NW < NEARLY;
        if (hb) { mb = cv_item(F, r + NW); cv_load(mb, F.lane, vb); }
        cv_finish(ma, F.lane, va, scr);
        if (r + 2 * NW < NEARLY) { ma = cv_item(F, r + 2 * NW); cv_load(ma, F.lane, va); }
        if (hb) cv_finish(mb, F.lane, vb, scr);
    }
}
__device__ __forceinline__ void moe_pull(Frame& F, int k, int until) {
    LAS int* q = (LAS int*)(F.lds + MISC_OFF + 64);
    LAS float* scr = (LAS float*)(F.lds + F.wave * 18432);
    gu32* qhead = F.ctl + CW_QHEAD; gu32* done = F.ctl + CW_DONE + 64 * (k < 0 ? 0 : k);
    bool first = true;
    for (;;) {
        __syncthreads();
        if (F.tid == 0) {
            if (first && k >= 0) __hip_atomic_fetch_add(done, 1u, RLX_AGENT);
            const bool go = k < 0 ? (int)__hip_atomic_load(qhead, RLX_AGENT) < until : (int)__hip_atomic_load(done, RLX_AGENT) < F.G;
            int f = -1; if (go) { f = (int)__hip_atomic_fetch_add(qhead, 64u, RLX_AGENT); if (f >= NQ) f = -1; }
            q[0] = f;
        }
        first = false;
        __syncthreads();
        const int f0 = q[0];
        if (f0 < 0) break;
        const int f = f0 + 8 * F.wave;
        f32x4 va[16], vb[16]; CvItem ma, mb;
        if (f < NQ) { ma = cv_item(F, NEARLY + f); cv_load(ma, F.lane, va); }
#pragma unroll 1
        for (int t = 0; t < 8; t += 2) {
            if (f + t + 1 < NQ) { mb = cv_item(F, NEARLY + f + t + 1); cv_load(mb, F.lane, vb); }
            if (f + t < NQ) cv_finish(ma, F.lane, va, scr);
            if (t + 2 < 8 && f + t + 2 < NQ) { ma = cv_item(F, NEARLY + f + t + 2); cv_load(ma, F.lane, va); }
            if (f + t + 1 < NQ) cv_finish(mb, F.lane, vb, scr);
        }
    }
}
__device__ __forceinline__ void p0_prologue(Frame& F) {
    for (int it = F.vcu; it < 192; it += F.G) { const int layer = it / 96, slab = it % 96;
        adaln_item(F, F.in[layer ? 16 : 4], F.in[layer ? 17 : 5], WSP(float, layer ? WS_MOD1 : WS_MOD0), slab); }
    { const int gt = F.vcu * 512 + F.tid; if (gt < 192 * 32) { const int pos = gt >> 5, i = gt & 31; const float inv = powf(10000.0f, -(float)i / 32.0f);
        const float ang = (float)(pos < 128 ? pos : pos - 128) * inv; float* rp = WSP(float, WS_ROPE); rp[gt] = cosf(ang); rp[192 * 32 + gt] = sinf(ang); } }
    __syncthreads();
    convert_dense(F);
}

template <bool F8, bool SRCH = false> __device__ __forceinline__ void norm_phase(Frame& F, const float* srcL, const float* srcC, const float* g, const float* mod, int shift_off, int scale_off, int nrows) {
    const int gw = F.vcu * NWAVES + F.wave, NGW = F.G * NWAVES;
    bf16* XN = WSP(bf16, WS_XN);
    for (int row = gw; row < nrows; row += NGW) {
        const float* src = row < ML ? srcL + (size_t)row * DM : srcC + (size_t)(row - ML) * DM;
        const float* mv = mod + (size_t)(row < ML ? (row >> 13) : 2) * MOD_W;
        const GAS f32x4* xr = (const GAS f32x4*)src + F.lane;
        f32x4 v[8]; float s = 0.f;
#pragma unroll
        for (int j = 0; j < 8; ++j) {
            if constexpr (SRCH) { const v2u w = ((const GAS v2u*)(WSP(const bf16, WS_H) + (size_t)row * DM))[F.lane + 64 * j]; v[j].x = bflo(w.x); v[j].y = bfhi(w.x); v[j].z = bflo(w.y); v[j].w = bfhi(w.y); }
            else v[j] = xr[64 * j];
            s += (v[j].x * v[j].x + v[j].y * v[j].y) + (v[j].z * v[j].z + v[j].w * v[j].w); }
        const float rstd = 1.0f / sqrtf(wave_sum(s) * (1.0f / DM) + NORM_EPS);
        GAS v2u* o8 = (GAS v2u*)(XN + (size_t)row * DM) + F.lane;
#pragma unroll
        for (int j = 0; j < 8; ++j) { const int col = 4 * (F.lane + 64 * j);
            const f32x4 gg = *(const GAS f32x4*)(g + col), sh = *(const GAS f32x4*)(mv + shift_off + col), sc = *(const GAS f32x4*)(mv + scale_off + col);
            const f32x4 y = v[j] * rstd * gg * (sc + 1.0f) + sh;
            if (F8) { ((GAS unsigned*)((unsigned char*)XN + (size_t)row * DM))[F.lane + 64 * j] = pk4_fp8(clamp8(y.x), clamp8(y.y), clamp8(y.z), clamp8(y.w)); }
            else { v2u w; w.x = pk2(y.x, y.y); w.y = pk2(y.z, y.w); o8[64 * j] = w; } }
    }
}
__device__ __forceinline__ void rope_conv_phase(Frame& F) {
    const int gw = F.vcu * NWAVES + F.wave, NGW = F.G * NWAVES;
    bf16* Z = WSP(bf16, WS_Z); bf16* AO = WSP(bf16, WS_AO); const float* rope = WSP(const float, WS_ROPE);
    const float* cw = F.in[9]; const float* cb = F.in[10];
    for (int row = gw; row < MT; row += NGW) {
        bf16* zr = Z + (size_t)row * EIN;
        if (row < ML) {
            const int t = row & (SEQ - 1);
#pragma unroll
            for (int ps = 0; ps < 3; ++ps) { const int li = ps * 64 + F.lane;
                if (li < 160) { const int hd = li >> 4, sub = li & 15, half = sub >> 3, d4 = (sub & 7) * 4;
                    const int col = (hd < 8 ? hd * 128 : 1024 + (hd - 8) * 128) + half * 64 + d4;
                    const int pos = half ? 128 + (t & 63) : (t >> 6);
                    const f32x4 cs = *(const GAS f32x4*)(rope + pos * 32 + d4), sn = *(const GAS f32x4*)(rope + 192 * 32 + pos * 32 + d4);
                    const v2u a = *(const GAS v2u*)(zr + col), b = *(const GAS v2u*)(zr + col + 32);
                    const float x0 = bflo(a.x), x1 = bfhi(a.x), x2 = bflo(a.y), x3 = bfhi(a.y), y0 = bflo(b.x), y1 = bfhi(b.x), y2 = bflo(b.y), y3 = bfhi(b.y);
                    v2u oa, ob; oa.x = pk2(x0 * cs.x - y0 * sn.x, x1 * cs.y - y1 * sn.y); oa.y = pk2(x2 * cs.z - y2 * sn.z, x3 * cs.w - y3 * sn.w);
                    ob.x = pk2(y0 * cs.x + x0 * sn.x, y1 * cs.y + x1 * sn.y); ob.y = pk2(y2 * cs.z + x2 * sn.z, y3 * cs.w + x3 * sn.w);
                    *(GAS v2u*)(zr + col) = oa; *(GAS v2u*)(zr + col + 32) = ob; } }
        }
        const int tt = row < ML ? (row & (SEQ - 1)) : ((row - ML) & (CTXL - 1)); const int tlen = row < ML ? SEQ : CTXL;
        const bool hp = tt > 0, hn = tt < tlen - 1;
#pragma unroll
        for (int ps = 0; ps < 2; ++ps) { const int ch = (ps * 64 + F.lane) * 8;
            const v4u z4 = {0u, 0u, 0u, 0u};
            const v4u xc_ = *(const GAS v4u*)(zr + 1536 + ch), gc_ = *(const GAS v4u*)(zr + 3584 + ch), bg = *(const GAS v4u*)(zr + 2560 + ch);
            const v4u xp = hp ? *(const GAS v4u*)(zr - EIN + 1536 + ch) : z4, gp = hp ? *(const GAS v4u*)(zr - EIN + 3584 + ch) : z4;
            const v4u xn = hn ? *(const GAS v4u*)(zr + EIN + 1536 + ch) : z4, gn = hn ? *(const GAS v4u*)(zr + EIN + 3584 + ch) : z4;
            float o[8];
#pragma unroll
            for (int j = 0; j < 4; ++j) {
#pragma unroll
                for (int e = 0; e < 2; ++e) { const int c = ch + 2 * j + e;
                    const float up = e ? bfhi(xp[j]) * bfhi(gp[j]) : bflo(xp[j]) * bflo(gp[j]);
                    const float uc = e ? bfhi(xc_[j]) * bfhi(gc_[j]) : bflo(xc_[j]) * bflo(gc_[j]);
                    const float un = e ? bfhi(xn[j]) * bfhi(gn[j]) : bflo(xn[j]) * bflo(gn[j]);
                    const float bgv = e ? bfhi(bg[j]) : bflo(bg[j]);
                    o[2 * j + e] = bgv * (cb[c] + cw[c] * up + cw[1024 + c] * uc + cw[2048 + c] * un); } }
            v4u w; w.x = pk2(o[0], o[1]); w.y = pk2(o[2], o[3]); w.z = pk2(o[4], o[5]); w.w = pk2(o[6], o[7]);
            *(GAS v4u*)(AO + (size_t)row * DM + 1024 + ch) = w; }
    }
    LAS unsigned short* scr = (LAS unsigned short*)(F.lds + F.wave * 16640);
    bf16* VT = WSP(bf16, WS_VT);
    for (int it = gw; it < (MT / 64) * 2; it += NGW) { const int kvh = it & 1, blk = it >> 1, row0 = blk * 64;
        const int rr = F.lane >> 4, c8 = (F.lane & 15) * 8;
#pragma unroll
        for (int i = 0; i < 16; ++i) { const v4u v = *(const GAS v4u*)(Z + (size_t)(row0 + 4 * i + rr) * EIN + 1280 + kvh * 128 + c8);
            LAS unsigned* p = (LAS unsigned*)(scr + (4 * i + rr) * 130 + c8); p[0] = v.x; p[1] = v.y; p[2] = v.z; p[3] = v.w; }
        LDS_WAIT(); asm volatile("" ::: "memory");
        const bool isc = row0 >= ML; const int bb = isc ? (row0 - ML) >> 8 : row0 >> 13, t0 = isc ? (row0 - ML) & 255 : row0 & (SEQ - 1), tl = isc ? CTXL : SEQ;
        bf16* dst = VT + (isc ? (size_t)ML * 256 : 0) + (size_t)(bb * 2 + kvh) * 128 * tl + t0;
        const int tc = F.lane & 7, dd = F.lane >> 3;
#pragma unroll
        for (int j = 0; j < 16; ++j) { const int d = dd + 8 * j; const LAS unsigned short* s = scr + (8 * tc) * 130 + d;
            v4u o; o.x = (unsigned)s[0] | ((unsigned)s[130] << 16); o.y = (unsigned)s[2 * 130] | ((unsigned)s[3 * 130] << 16);
            o.z = (unsigned)s[4 * 130] | ((unsigned)s[5 * 130] << 16); o.w = (unsigned)s[6 * 130] | ((unsigned)s[7 * 130] << 16);
            *(GAS v4u*)(dst + (size_t)d * tl + 8 * tc) = o; }
        LDS_WAIT(); asm volatile("" ::: "memory");
    }
}

__device__ __forceinline__ int crow(int r, int hh) { return (r & 3) + 8 * (r >> 2) + 4 * hh; }
__device__ __forceinline__ bool attn_tile_ok(int i, int qb) { if (i < 4) return true; const int ks = qb * 64 - 128 + 64 * (i - 4); return ks >= 0 && ks < SEQ; }
__device__ __forceinline__ void attn_issue(const bf16* Z, const bf16* VT, int i, int b, int kvh, int qb, int tid, v4u (&kreg)[2], v4u (&vreg)[2]) {
    const bf16* kbase; const bf16* vbase; int tl;
    if (i < 4) { kbase = Z + (size_t)(ML + b * CTXL + 64 * i) * EIN + 1024 + kvh * 128; vbase = VT + (size_t)ML * 256 + (size_t)(b * 2 + kvh) * 128 * CTXL + 64 * i; tl = CTXL; }
    else { const int ks = qb * 64 - 128 + 64 * (i - 4); kbase = Z + (size_t)(b * SEQ + ks) * EIN + 1024 + kvh * 128; vbase = VT + (size_t)(b * 2 + kvh) * 128 * SEQ + ks; tl = SEQ; }
#pragma unroll
    for (int e = 0; e < 2; ++e) { const int id = tid + 512 * e;
        kreg[e] = *(const GAS v4u*)(kbase + (size_t)(id >> 4) * EIN + (id & 15) * 8);
        vreg[e] = *(const GAS v4u*)(vbase + (size_t)(id >> 3) * tl + (id & 7) * 8); }
}
__device__ __forceinline__ void attn_phase(Frame& F) {
    const bf16* Z = WSP(const bf16, WS_Z); const bf16* VT = WSP(const bf16, WS_VT); bf16* AO = WSP(bf16, WS_AO);
    const float* sinks = F.in[8];
    LAS unsigned char* KL = F.lds; LAS unsigned char* VL = F.lds + 17408;
    const int r = F.lane & 31, hh = F.lane >> 5, g = F.wave >> 1, qs = (F.wave & 1) * 32;
    constexpr float CSC = 0.08838834764831845f * 1.4426950408889634f;
    for (int u = F.vcu; u < 528; u += F.G) {
        const bool isc = u >= 512; int b, kvh, qb;
        if (!isc) { b = u >> 8; kvh = (u >> 7) & 1; qb = u & 127; } else { const int v = u - 512; b = v >> 3; kvh = (v >> 2) & 1; qb = v & 3; }
        const int qrow0 = isc ? ML + b * CTXL + qb * 64 : b * SEQ + qb * 64, head = kvh * 4 + g;
        bf16x8 qf[8];
        { const bf16* qp = Z + (size_t)(qrow0 + qs + r) * EIN + head * 128 + 8 * hh;
#pragma unroll
          for (int s = 0; s < 8; ++s) qf[s] = *(const GAS bf16x8*)(qp + 16 * s); }
        const float tsink = sinks[head] * 1.4426950408889634f;
        float m = tsink, l = 0.f;
        f32x16 o[4];
#pragma unroll
        for (int dg = 0; dg < 4; ++dg)
#pragma unroll
            for (int i = 0; i < 16; ++i) o[dg][i] = 0.f;
        const int ntile = isc ? 4 : 9;
        v4u kreg[2][2], vreg[2][2];
        int tcur = 0, tnxt = 1; while (tnxt < ntile && !attn_tile_ok(tnxt, qb)) ++tnxt;
        attn_issue(Z, VT, tcur, b, kvh, qb, F.tid, kreg[0], vreg[0]);
        if (tnxt < ntile) attn_issue(Z, VT, tnxt, b, kvh, qb, F.tid, kreg[1], vreg[1]);
        bool more = true;
        while (more) {
#pragma unroll
          for (int hs = 0; hs < 2; ++hs) { if (more) {
            const int cur = tcur;
            LDS_BARRIER();
#pragma unroll
            for (int e = 0; e < 2; ++e) { const int id = F.tid + 512 * e;
                *(LAS v4u*)(KL + (id >> 4) * 272 + (id & 15) * 16) = kreg[hs][e];
                LAS v2u* vp = (LAS v2u*)(VL + (id >> 3) * 136 + (id & 7) * 16); v2u lo, hi; lo.x = vreg[hs][e].x; lo.y = vreg[hs][e].y; hi.x = vreg[hs][e].z; hi.y = vreg[hs][e].w; vp[0] = lo; vp[1] = hi; }
            LDS_BARRIER();
            int t2 = tnxt + 1; while (t2 < ntile && !attn_tile_ok(t2, qb)) ++t2;
            if (tnxt < ntile && t2 < ntile) attn_issue(Z, VT, t2, b, kvh, qb, F.tid, kreg[hs], vreg[hs]);
            f32x16 sc[2];
#pragma unroll
            for (int kg = 0; kg < 2; ++kg) {
#pragma unroll
                for (int i = 0; i < 16; ++i) sc[kg][i] = 0.f;
#pragma unroll
                for (int s = 0; s < 8; ++s) { const bf16x8 kf = *(const LAS bf16x8*)(KL + (32 * kg + r) * 272 + (16 * s + 8 * hh) * 2);
                    sc[kg] = __builtin_amdgcn_mfma_f32_32x32x16_bf16(kf, qf[s], sc[kg], 0, 0, 0); } }
            const int mode = (cur == 4) ? 1 : (cur == 8 ? 2 : 0);
            float tmax = -3.0e38f;
#pragma unroll
            for (int kg = 0; kg < 2; ++kg)
#pragma unroll
                for (int i = 0; i < 16; ++i) { float t = sc[kg][i] * CSC; const int kk = 32 * kg + crow(i, hh), qq = qs + r;
                    if ((mode == 1 && kk < qq) || (mode == 2 && kk > qq)) t = -1.0e30f;
                    sc[kg][i] = t; tmax = fmaxf(tmax, t); }
            tmax = fmaxf(tmax, __shfl_xor(tmax, 32));
            const float mn = fmaxf(m, tmax), alpha = __builtin_amdgcn_exp2f(m - mn); m = mn;
            float ps = 0.f;
#pragma unroll
            for (int kg = 0; kg < 2; ++kg)
#pragma unroll
                for (int i = 0; i < 16; ++i) { const float p = __builtin_amdgcn_exp2f(sc[kg][i] - m); sc[kg][i] = p; ps += p; }
            l = l * alpha + ps;
#pragma unroll
            for (int dg = 0; dg < 4; ++dg)
#pragma unroll
                for (int i = 0; i < 16; ++i) o[dg][i] *= alpha;
#pragma unroll
            for (int kg = 0; kg < 2; ++kg)
#pragma unroll
                for (int s2 = 0; s2 < 2; ++s2) { v4u pw; pw.x = pk2(sc[kg][8 * s2 + 0], sc[kg][8 * s2 + 1]); pw.y = pk2(sc[kg][8 * s2 + 2], sc[kg][8 * s2 + 3]);
                    pw.z = pk2(sc[kg][8 * s2 + 4], sc[kg][8 * s2 + 5]); pw.w = pk2(sc[kg][8 * s2 + 6], sc[kg][8 * s2 + 7]);
                    const bf16x8 pf = __builtin_bit_cast(bf16x8, pw);
#pragma unroll
                    for (int dg = 0; dg < 4; ++dg) { const LAS unsigned char* vb = VL + (32 * dg + r) * 136 + (32 * kg + 16 * s2 + 4 * hh) * 2;
                        const v2u lo = *(const LAS v2u*)vb, hi = *(const LAS v2u*)(vb + 16); v4u vw; vw.x = lo.x; vw.y = lo.y; vw.z = hi.x; vw.w = hi.y;
                        o[dg] = __builtin_amdgcn_mfma_f32_32x32x16_bf16(__builtin_bit_cast(bf16x8, vw), pf, o[dg], 0, 0, 0); } }
            more = tnxt < ntile; tcur = tnxt; tnxt = t2;
          } }
        }
        const float lt = l + __shfl_xor(l, 32) + __builtin_amdgcn_exp2f(tsink - m), inv = 1.0f / lt;
        bf16* op = AO + (size_t)(qrow0 + qs + r) * DM + head * 128;
#pragma unroll
        for (int dg = 0; dg < 4; ++dg)
#pragma unroll
            for (int g4 = 0; g4 < 4; ++g4) { v2u w; w.x = pk2(o[dg][4 * g4 + 0] * inv, o[dg][4 * g4 + 1] * inv); w.y = pk2(o[dg][4 * g4 + 2] * inv, o[dg][4 * g4 + 3] * inv);
                *(GAS v2u*)(op + 32 * dg + 8 * g4 + 4 * hh) = w; }
    }
}
template <bool FINAL, int z> __device__ __forceinline__ void rglru_blocks(LAS unsigned char* XCB, LAS float* XCF, LAS float* HS, const bf16x8 (&wa)[8], const bf16x8 (&wx)[8],
        float ba, float bxx, float sp8, int r, int hh, int chl, float& st, float& CA, float& CB) {
#pragma unroll
        for (int bi = 0; bi < 2; ++bi) { const int tb = z ? 1 - bi : bi;
            if (z == 1 && bi == 0) __builtin_amdgcn_s_sleep(8);
            f32x16 ya, yx;
#pragma unroll
            for (int i = 0; i < 16; ++i) { ya[i] = ba; yx[i] = bxx; }
#pragma unroll
            for (int s = 0; s < 8; ++s) { const bf16x8 af = *(const LAS bf16x8*)(XCB + (32 * tb + r) * 272 + (16 * s + 8 * hh) * 2);
                ya = __builtin_amdgcn_mfma_f32_32x32x16_bf16(af, wa[s], ya, 0, 0, 0); yx = __builtin_amdgcn_mfma_f32_32x32x16_bf16(af, wx[s], yx, 0, 0, 0); }
            float av[16], bv[16];
#pragma unroll
            for (int i = 0; i < 16; i += 2) {
                typedef float f2 __attribute__((ext_vector_type(2)));
                const f2 xc = {XCF[(32 * tb + crow(i, hh)) * 128 + chl], XCF[(32 * tb + crow(i + 1, hh)) * 128 + chl]};
                const f2 ta = (f2){ya[i], ya[i + 1]} * -1.4426950408889634f, tx = (f2){yx[i], yx[i + 1]} * -1.4426950408889634f;
                f2 ea, ex; ea.x = __builtin_amdgcn_exp2f(ta.x); ea.y = __builtin_amdgcn_exp2f(ta.y); ex.x = __builtin_amdgcn_exp2f(tx.x); ex.y = __builtin_amdgcn_exp2f(tx.y);
                const f2 da = ea + 1.0f, dx = ex + 1.0f;
                f2 rg, ig; rg.x = __builtin_amdgcn_rcpf(da.x); rg.y = __builtin_amdgcn_rcpf(da.y); ig.x = __builtin_amdgcn_rcpf(dx.x); ig.y = __builtin_amdgcn_rcpf(dx.y);
                const f2 la = rg * sp8; f2 a; a.x = __builtin_amdgcn_exp2f(la.x); a.y = __builtin_amdgcn_exp2f(la.y);
                const f2 om = a * -a + 1.0f; f2 sq; sq.x = __builtin_amdgcn_sqrtf(om.x); sq.y = __builtin_amdgcn_sqrtf(om.y);
                const f2 b = sq * ig * xc;
                av[i] = a.x; av[i + 1] = a.y; bv[i] = b.x; bv[i + 1] = b.y; }
            float Ag[4], Bg[4], Ap[4], Bp[4];
#pragma unroll
            for (int g = 0; g < 4; ++g) { float A = 1.f, B = 0.f;
#pragma unroll
                for (int k = 0; k < 4; ++k) { const int kk = z ? 3 - k : k; B = B * av[4 * g + kk] + bv[4 * g + kk]; A *= av[4 * g + kk]; }
                Ag[g] = A; Bg[g] = B; Ap[g] = __shfl_xor(A, 32); Bp[g] = __shfl_xor(B, 32); }
            float ent[4]; float cur = st;
#pragma unroll
            for (int gi = 0; gi < 4; ++gi) { const int g = z ? 3 - gi : gi;
                const bool own_first = z ? (hh == 1) : (hh == 0);
                if (own_first) { ent[g] = cur; cur = Ag[g] * cur + Bg[g]; CB = Ag[g] * CB + Bg[g]; CA *= Ag[g]; cur = Ap[g] * cur + Bp[g]; CB = Ap[g] * CB + Bp[g]; CA *= Ap[g]; }
                else { cur = Ap[g] * cur + Bp[g]; CB = Ap[g] * CB + Bp[g]; CA *= Ap[g]; ent[g] = cur; cur = Ag[g] * cur + Bg[g]; CB = Ag[g] * CB + Bg[g]; CA *= Ag[g]; } }
            st = cur;
            if (FINAL) {
#pragma unroll
                for (int g = 0; g < 4; ++g) { float hc = ent[g];
#pragma unroll
                    for (int k = 0; k < 4; ++k) { const int kk = z ? 3 - k : k; hc = av[4 * g + kk] * hc + bv[4 * g + kk];
                        HS[(z * 64 + 32 * tb + 8 * g + 4 * hh + kk) * 128 + chl] = hc; } } }
        }
}
template <bool FINAL> __device__ __forceinline__ void rglru_pass(Frame& F) {
    const bf16* Z1 = WSP(const bf16, WS_Z); const bf16* WGT = WSP(const bf16, WS_WGT); bf16* AO = WSP(bf16, WS_AO);
    float* SUM = WSP(float, WS_SUM);
    const float* cw = F.in[20]; const float* cb = F.in[21];
    LAS unsigned char* XCB = F.lds;
    LAS float* XCF = (LAS float*)(F.lds + 17408);
    LAS float* HS = (LAS float*)(F.lds + 17408 + 32768);
    const int bx = blockIdx.x, h = bx & 15, cg = bx >> 4, ncg = F.G >> 4;
    if (cg >= ncg) return;
    const int r = F.lane & 31, hh = F.lane >> 5, jg = F.wave & 3, z = F.wave >> 2;
    const int chl = 32 * jg + r, ch = h * 128 + chl;
    bf16x8 wa[8], wx[8];
    { const bf16* pa = WGT + ((size_t)((z * 2 + 0) * 16 + h) * 128 + chl) * 128 + 8 * hh; const bf16* px = WGT + ((size_t)((z * 2 + 1) * 16 + h) * 128 + chl) * 128 + 8 * hh;
#pragma unroll
      for (int s = 0; s < 8; ++s) { wa[s] = *(const GAS bf16x8*)(pa + 16 * s); wx[s] = *(const GAS bf16x8*)(px + 16 * s); } }
    const float ba = F.in[23][z * DM + ch], bxx = F.in[25][z * DM + ch];
    const float sp8 = -8.0f * 1.4426950408889634f * log1pf(__expf(-F.in[26][z * DM + ch]));
    const int nch = FINAL ? 256 : NCHUNK;
    LAS float* CWL = (LAS float*)(F.lds + 17408 + 32768 + 65536);
    __syncthreads();
    for (int i = F.tid; i < 640; i += 512) CWL[i] = i < 512 ? cw[(i >> 7) * DM + h * 128 + (i & 127)] : cb[h * 128 + (i - 512)];
    __syncthreads();
    LAS float* CL = (LAS float*)(F.lds + 17408 + 32768 + 65536 + 2560);
    if (FINAL) { const int b = F.tid >> 8, zz = (F.tid >> 7) & 1, cl = F.tid & 127; const float* sb = SUM + ((size_t)zz * DM + h * 128 + cl) * 2;
        float s = 0.f;
#pragma unroll
        for (int i = 0; i < 4; ++i) { const int c = 256 + b * 4 + (zz ? 3 - i : i); const float2 ab = *(const float2*)(sb + (size_t)c * 4 * DM); s = ab.x * s + ab.y; }
#pragma unroll 8
        for (int i = 0; i < 128; ++i) { const int c = b * 128 + (zz ? 127 - i : i); const float2 ab = *(const float2*)(sb + (size_t)c * 4 * DM);
            const int d = c - cg; if (d >= 0 && d % ncg == 0) CL[(d / ncg) * 256 + zz * 128 + cl] = s;
            s = ab.x * s + ab.y; }
        __syncthreads(); }
    v4u xq[2][4];
#define RG_LOAD_ROWS(cc) do { const int _row0 = (cc) < 256 ? (cc) * 64 : ML + ((cc) - 256) * 64; \
        const int _s0 = (cc) < 256 ? ((cc) >> 7) * SEQ : ML + (((cc) - 256) >> 2) * CTXL, _s1 = _s0 + ((cc) < 256 ? SEQ : CTXL); \
        _Pragma("unroll") for (int it = 0; it < 2; ++it) { const int id = F.tid + 512 * it, row = _row0 + (id >> 4), gc = h * 128 + (id & 15) * 8; \
            _Pragma("unroll") for (int tap = 0; tap < 4; ++tap) { const int rr = row + tap - 2; v4u x = {0u, 0u, 0u, 0u}; \
                if (rr >= _s0 && rr < _s1) x = *(const GAS v4u*)(Z1 + (size_t)rr * 4096 + 2048 + gc); xq[it][tap] = x; } } } while (0)
    if (cg < nch) RG_LOAD_ROWS(cg);
    for (int c = cg; c < nch; c += ncg) {
        const int row0 = c < 256 ? c * 64 : ML + (c - 256) * 64;
        LDS_BARRIER();
#pragma unroll
        for (int it = 0; it < 2; ++it) { const int id = F.tid + 512 * it, t = id >> 4, c8 = (id & 15) * 8;
            float a[8];
            { const f32x4 b0 = *(const LAS f32x4*)(CWL + 512 + c8), b1 = *(const LAS f32x4*)(CWL + 512 + c8 + 4);
              a[0] = b0.x; a[1] = b0.y; a[2] = b0.z; a[3] = b0.w; a[4] = b1.x; a[5] = b1.y; a[6] = b1.z; a[7] = b1.w; }
#pragma unroll
            for (int tap = 0; tap < 4; ++tap) { const v4u x = xq[it][tap];
                const f32x4 w0 = *(const LAS f32x4*)(CWL + tap * 128 + c8), w1 = *(const LAS f32x4*)(CWL + tap * 128 + c8 + 4);
                a[0] += w0.x * bflo(x[0]); a[1] += w0.y * bfhi(x[0]); a[2] += w0.z * bflo(x[1]); a[3] += w0.w * bfhi(x[1]);
                a[4] += w1.x * bflo(x[2]); a[5] += w1.y * bfhi(x[2]); a[6] += w1.z * bflo(x[3]); a[7] += w1.w * bfhi(x[3]); }
            *(LAS f32x4*)(XCF + t * 128 + c8) = (f32x4){a[0], a[1], a[2], a[3]}; *(LAS f32x4*)(XCF + t * 128 + c8 + 4) = (f32x4){a[4], a[5], a[6], a[7]};
            v4u w; w.x = pk2(a[0], a[1]); w.y = pk2(a[2], a[3]); w.z = pk2(a[4], a[5]); w.w = pk2(a[6], a[7]);
            *(LAS v4u*)(XCB + t * 272 + c8 * 2) = w; }
        LDS_BARRIER();
        if (c + ncg < nch) RG_LOAD_ROWS(c + ncg);
        v4u gq[2];
        if (FINAL) {
#pragma unroll
            for (int it = 0; it < 2; ++it) { const int id = F.tid + 512 * it; gq[it] = *(const GAS v4u*)(Z1 + (size_t)(row0 + (id >> 4)) * 4096 + h * 128 + (id & 15) * 8); } }
        float st = 0.f, CA = 1.f, CB = 0.f;
        if (FINAL) st = CL[((c - cg) / ncg) * 256 + z * 128 + chl];
        if (z == 0) rglru_blocks<FINAL, 0>(XCB, XCF, HS, wa, wx, ba, bxx, sp8, r, hh, chl, st, CA, CB);
        else rglru_blocks<FINAL, 1>(XCB, XCF, HS, wa, wx, ba, bxx, sp8, r, hh, chl, st, CA, CB);
        if (!FINAL) { if (hh == 0) { float* sp = SUM + (((size_t)c * 2 + z) * DM + ch) * 2; sp[0] = CA; sp[1] = CB; } }
        else {
            LDS_BARRIER();
#pragma unroll
            for (int it = 0; it < 2; ++it) { const int id = F.tid + 512 * it, t = id >> 4, c8 = (id & 15) * 8, row = row0 + t, gc = h * 128 + c8;
                const f32x4 f0 = *(const LAS f32x4*)(HS + t * 128 + c8), f1 = *(const LAS f32x4*)(HS + t * 128 + c8 + 4);
                const f32x4 b0 = *(const LAS f32x4*)(HS + (64 + t) * 128 + c8), b1 = *(const LAS f32x4*)(HS + (64 + t) * 128 + c8 + 4);
                const v4u gt = gq[it];
                v4u w; w.x = pk2((f0.x + b0.x) * bflo(gt.x), (f0.y + b0.y) * bfhi(gt.x)); w.y = pk2((f0.z + b0.z) * bflo(gt.y), (f0.w + b0.w) * bfhi(gt.y));
                w.z = pk2((f1.x + b1.x) * bflo(gt.z), (f1.y + b1.y) * bfhi(gt.z)); w.w = pk2((f1.z + b1.z) * bflo(gt.w), (f1.w + b1.w) * bfhi(gt.w));
                *(GAS v4u*)(AO + (size_t)row * DM + gc) = w; }
        }
    }
#undef RG_LOAD_ROWS
}
__device__ __forceinline__ void route_phase(Frame& F) {
    const float* g = F.in[28]; const float* mod = WSP(const float, WS_MOD1); const float* rw = F.in[29]; const float* rb = F.in[30];
    bf16* XN = WSP(bf16, WS_XN);
    int* tok_e = WSP(int, WS_ROUTE); int* tok_rank = tok_e + 2 * ML; float* tok_w = (float*)(tok_rank + 2 * ML);
    LAS int* lcnt = (LAS int*)(F.lds); LAS int* lbase = lcnt + 8;
    LAS int* lrow = lcnt + 16;
    LAS f32x4* rwl = (LAS f32x4*)(F.lds + 2048);
    __syncthreads();
    for (int s4 = F.tid; s4 < 4096; s4 += 512) { const int k = s4 >> 1, half = s4 & 1, j = k >> 8, ln = (k >> 2) & 63, q = k & 3;
        rwl[((j * 4 + q) * 2 + half) * 64 + ln] = *(const GAS f32x4*)(rw + (size_t)k * 8 + 4 * half); }
    __syncthreads();
    for (int base = F.vcu * 64; base < ML; base += F.G * 64) {
        __syncthreads();
        if (F.tid < 8) lcnt[F.tid] = 0;
        __syncthreads();
        for (int i = 0; i < 8; ++i) { const int row = base + F.wave * 8 + i;
            const float* mv = mod + (size_t)(row >> 13) * MOD_W;
            const GAS v2u* xr = (const GAS v2u*)(WSP(const bf16, WS_H) + (size_t)row * DM) + F.lane;
            f32x4 v[8]; float s = 0.f;
#pragma unroll
            for (int j = 0; j < 8; ++j) { const v2u w = xr[64 * j]; v[j].x = bflo(w.x); v[j].y = bfhi(w.x); v[j].z = bflo(w.y); v[j].w = bfhi(w.y); s += (v[j].x * v[j].x + v[j].y * v[j].y) + (v[j].z * v[j].z + v[j].w * v[j].w); }
            const float rstd = 1.0f / sqrtf(wave_sum(s) * (1.0f / DM) + NORM_EPS);
            GAS unsigned* o4 = (GAS unsigned*)((unsigned char*)XN + (size_t)row * DM) + F.lane;
            float lg[8];
#pragma unroll
            for (int e = 0; e < 8; ++e) lg[e] = 0.f;
#pragma unroll
            for (int j = 0; j < 8; ++j) { const int col = 4 * (F.lane + 64 * j);
                const f32x4 gg = *(const GAS f32x4*)(g + col), sh = *(const GAS f32x4*)(mv + 3 * DM + col), sc = *(const GAS f32x4*)(mv + 4 * DM + col);
                const f32x4 y = v[j] * rstd * gg * (sc + 1.0f) + sh; o4[64 * j] = pk4_fp8(clamp8(y.x), clamp8(y.y), clamp8(y.z), clamp8(y.w));
#pragma unroll
                for (int q = 0; q < 4; ++q) { const f32x4 w0 = rwl[((j * 4 + q) * 2 + 0) * 64 + F.lane], w1 = rwl[((j * 4 + q) * 2 + 1) * 64 + F.lane];
                    lg[0] += y[q] * w0.x; lg[1] += y[q] * w0.y; lg[2] += y[q] * w0.z; lg[3] += y[q] * w0.w; lg[4] += y[q] * w1.x; lg[5] += y[q] * w1.y; lg[6] += y[q] * w1.z; lg[7] += y[q] * w1.w; } }
#pragma unroll
            for (int e = 0; e < 8; ++e) lg[e] = wave_sum(lg[e]) + rb[e];
            int e0 = 0; float l0 = lg[0];
#pragma unroll
            for (int e = 1; e < 8; ++e) if (lg[e] > l0) { l0 = lg[e]; e0 = e; }
            int e1 = -1; float l1 = -3.0e38f;
#pragma unroll
            for (int e = 0; e < 8; ++e) if (e != e0 && lg[e] > l1) { l1 = lg[e]; e1 = e; }
            if (F.lane == 0) { const float w1 = 1.0f / (1.0f + __expf(l0 - l1)); const int r0 = atomicAdd((int*)&lcnt[e0], 1), r1 = atomicAdd((int*)&lcnt[e1], 1);
                LAS int* pr = lrow + (F.wave * 8 + i) * 4; pr[0] = e0; pr[1] = r0; pr[2] = e1; pr[3] = r1;
                tok_e[2 * row] = e0; tok_e[2 * row + 1] = e1; tok_w[2 * row] = 1.0f - w1; tok_w[2 * row + 1] = w1; }
        }
        __syncthreads();
        if (F.tid < 8) lbase[F.tid] = (int)__hip_atomic_fetch_add((unsigned*)(F.ctl + CW_CNT + F.tid), (unsigned)lcnt[F.tid], RLX_AGENT);
        __syncthreads();
        if (F.tid < 64) { const int row = base + F.tid; const LAS int* pr = lrow + F.tid * 4; tok_rank[2 * row] = lbase[pr[0]] + pr[1]; tok_rank[2 * row + 1] = lbase[pr[2]] + pr[3]; }
        VM_WAIT();
        { unsigned char* XGS = F.ws + WS_XGS;
#pragma unroll
          for (int i = 0; i < 8; ++i) { const int row = base + F.wave * 8 + i; const LAS int* pr = lrow + (F.wave * 8 + i) * 4;
              const v4u* src = (const v4u*)((const unsigned char*)XN + (size_t)row * DM) + F.lane;
              const v4u x0 = __builtin_nontemporal_load((const GAS v4u*)src), x1 = __builtin_nontemporal_load((const GAS v4u*)(src + 64));
#pragma unroll
              for (int sl = 0; sl < 2; ++sl) { const int e = pr[2 * sl], rk = lbase[e] + pr[2 * sl + 1];
                  GAS v4u* dst = (GAS v4u*)(XGS + ((size_t)e * ML + rk) * DM) + F.lane; dst[0] = x0; dst[64] = x1; } } }
    }
}
__device__ __forceinline__ void gather_phase(Frame& F) {
    const bf16* XN = WSP(const bf16, WS_XN); bf16* XG = WSP(bf16, WS_Z);
    const int* tok_e = WSP(const int, WS_ROUTE); const int* tok_rank = tok_e + 2 * ML;
    int off[8]; { int t = 0;
#pragma unroll
        for (int e = 0; e < 8; ++e) { off[e] = t; t += ((__builtin_amdgcn_readfirstlane((int)F.ctl[CW_CNT + e]) + 255) >> 8) << 8; } }
    const int gw = F.vcu * NWAVES + F.wave, NGW = F.G * NWAVES;
    for (int a = gw; a < 2 * ML; a += NGW) { const int row = a >> 1, e = tok_e[a], rk = tok_rank[a]; int o = 0;
#pragma unroll
        for (int k = 0; k < 8; ++k) o = (e == k) ? off[k] : o;
        const GAS v4u* src = (const GAS v4u*)((const unsigned char*)XN + (size_t)row * DM) + F.lane; GAS v4u* dst = (GAS v4u*)((unsigned char*)XG + (size_t)(o + rk) * DM) + F.lane;
#pragma unroll
        for (int j = 0; j < 2; ++j) dst[64 * j] = src[64 * j]; }
}
__device__ __forceinline__ f32x4 y2_load(Frame& F, const bf16* Y2, size_t s, int col) {
    f32x4 r;
    if (s < (size_t)Y2_FULL_TILES * 256 * DM) { const v2u y = *(const GAS v2u*)(Y2 + s + col); r.x = bflo(y.x); r.y = bfhi(y.x); r.z = bflo(y.y); r.w = bfhi(y.y); }
    else { const bf16* P = WSP(const bf16, WS_XN) + (s - (size_t)Y2_FULL_TILES * 256 * DM) + col; r = (f32x4){0.f, 0.f, 0.f, 0.f};
#pragma unroll
        for (int p = 0; p < 7; ++p) { const v2u y = *(const GAS v2u*)(P + (size_t)p * Y2_PART_ROWS * DM); r.x += bflo(y.x); r.y += bfhi(y.x); r.z += bflo(y.y); r.w += bfhi(y.y); } }
    return r;
}
__device__ __forceinline__ void final_phase(Frame& F) {
    const bf16* Y2 = WSP(const bf16, WS_Z); const float* mod = WSP(const float, WS_MOD1); const float* fg = F.in[34];
    const int* tok_e = WSP(const int, WS_ROUTE); const int* tok_rank = tok_e + 2 * ML; const float* tok_w = (const float*)(tok_rank + 2 * ML);
    int off[8]; { int t = 0;
#pragma unroll
        for (int e = 0; e < 8; ++e) { off[e] = t; t += ((__builtin_amdgcn_readfirstlane((int)F.ctl[CW_CNT + e]) + 255) >> 8) << 8; } }
    const int gw = F.vcu * NWAVES + F.wave, NGW = F.G * NWAVES;
    for (int row = gw; row < ML; row += NGW) {
        const int e0 = tok_e[2 * row], e1 = tok_e[2 * row + 1]; int o0 = 0, o1 = 0;
#pragma unroll
        for (int k = 0; k < 8; ++k) { o0 = (e0 == k) ? off[k] : o0; o1 = (e1 == k) ? off[k] : o1; }
        const size_t s0 = (size_t)(o0 + tok_rank[2 * row]) * DM, s1 = (size_t)(o1 + tok_rank[2 * row + 1]) * DM; const float w0 = tok_w[2 * row], w1 = tok_w[2 * row + 1];
        const float* g2 = mod + (size_t)(row >> 13) * MOD_W + 5 * DM;
        GAS f32x4* xr = (GAS f32x4*)(F.out + (size_t)row * DM) + F.lane;
        const GAS v2u* hr = (const GAS v2u*)(WSP(const bf16, WS_H) + (size_t)row * DM) + F.lane;
        f32x4 v[8]; float s = 0.f;
        const bool tail = __builtin_amdgcn_readfirstlane((int)((s0 >= (size_t)Y2_FULL_TILES * 256 * DM) | (s1 >= (size_t)Y2_FULL_TILES * 256 * DM))) != 0;
        if (!tail) {
#pragma unroll
            for (int j = 0; j < 8; ++j) { const int col = 4 * (F.lane + 64 * j);
                const v2u ya = *(const GAS v2u*)(Y2 + s0 + col), yb = *(const GAS v2u*)(Y2 + s1 + col); const f32x4 gg = *(const GAS f32x4*)(g2 + col);
                f32x4 mo; mo.x = w0 * bflo(ya.x) + w1 * bflo(yb.x); mo.y = w0 * bfhi(ya.x) + w1 * bfhi(yb.x); mo.z = w0 * bflo(ya.y) + w1 * bflo(yb.y); mo.w = w0 * bfhi(ya.y) + w1 * bfhi(yb.y);
                { const v2u hw = hr[64 * j]; f32x4 hv; hv.x = bflo(hw.x); hv.y = bfhi(hw.x); hv.z = bflo(hw.y); hv.w = bfhi(hw.y); v[j] = hv + gg * mo; } s += (v[j].x * v[j].x + v[j].y * v[j].y) + (v[j].z * v[j].z + v[j].w * v[j].w); }
        } else {
#pragma unroll
            for (int j = 0; j < 8; ++j) { const int col = 4 * (F.lane + 64 * j);
                const f32x4 fa = y2_load(F, Y2, s0, col), fb = y2_load(F, Y2, s1, col); const f32x4 gg = *(const GAS f32x4*)(g2 + col);
                const f32x4 mo = w0 * fa + w1 * fb;
                { const v2u hw = hr[64 * j]; f32x4 hv; hv.x = bflo(hw.x); hv.y = bfhi(hw.x); hv.z = bflo(hw.y); hv.w = bfhi(hw.y); v[j] = hv + gg * mo; } s += (v[j].x * v[j].x + v[j].y * v[j].y) + (v[j].z * v[j].z + v[j].w * v[j].w); }
        }
        const float rstd = 1.0f / sqrtf(wave_sum(s) * (1.0f / DM) + NORM_EPS);
#pragma unroll
        for (int j = 0; j < 8; ++j) { const int col = 4 * (F.lane + 64 * j); xr[64 * j] = v[j] * rstd * *(const GAS f32x4*)(fg + col); }
    }
}
constexpr int N_PHASES = 20;
#ifndef MK_ONE_LAUNCH
#define MK_ONE_LAUNCH 1
#endif
__global__ void __launch_bounds__(NWAVES * 64, 2) fwd_kernel(Args args) {
    extern __shared__ __attribute__((aligned(16))) unsigned char lds_raw[];
    Frame F;
    F.lds = (LAS unsigned char*)lds_raw;
    F.tid = threadIdx.x; F.lane = F.tid & 63; F.wave = __builtin_amdgcn_readfirstlane(F.tid >> 6);
    F.G = gridDim.x; { const int bx = blockIdx.x; F.vcu = (F.G % 8 == 0) ? (bx % 8) * (F.G / 8) + bx / 8 : bx; }
    F.in = args.in; F.out = args.out; F.ws = args.ws; F.ctl = (gu32*)(args.ws + WS_CTL);
    volatile LAS unsigned* MISC = (volatile LAS unsigned*)(F.lds + MISC_OFF);
    for (int u = F.tid; u < (LDS_BYTES - MISC_OFF) / 4; u += NWAVES * 64) MISC[u] = 0u;
    __syncthreads();
    const int lo = args.ph_lo, hi = args.ph_hi;
    XcdBarrier bar = xcd_barrier_post((unsigned*)(F.ctl + CW_BAR), MISC + 8, (unsigned)gridDim.x);
#ifdef ONLY_PH
#define IN(k) ((k) == ONLY_PH)
#else
#define IN(k) (lo <= (k) && (k) < hi)
#endif
#ifndef MK_NCV7
#define MK_NCV7 56
#endif
#ifndef MK_NCV8
#define MK_NCV8 80
#endif
#ifndef MK_TAIL_MASK
#define MK_TAIL_MASK ((1u << 7) | (1u << 8))
#endif
#define SEAM(k) do { if (IN(k) && IN((k) + 1)) { if ((MK_TAIL_MASK >> (k)) & 1u) moe_pull(F, (k), 0); if ((k) == 9) moe_pull(F, -1, NQ_LATE); if ((k) == 15) moe_pull(F, -1, NQ); xcd_barrier(bar); { int t_ = threadIdx.x; asm volatile("" : "+v"(t_)); F.tid = t_; F.lane = t_ & 63; } } } while (0)
    const pg8::bf16_t* XN = WSP(const pg8::bf16_t, WS_XN);

    if (IN(0)) { p0_prologue(F); } SEAM(0);
    if (IN(1)) { norm_phase<false>(F, F.in[0], F.in[2], F.in[6], WSP(const float, WS_MOD0), 0, DM, MT); } SEAM(1);
    if (IN(2)) { pg8::Gemm g{XN, WSP(const pg8::bf16_t, WS_WIN0), MT, EIN, DM, 0, DM, 0, 0}; pg8::StaticOrder S; S.init(MT, EIN, F.G, (int)blockIdx.x);
        pg8::EpiBf16 E{WSP(pg8::bf16_t, WS_Z), EIN, 0, 0, 1.0f};
        pg8::gemm_phase<pg8::EpiBf16, pg8::StaticOrder, true, true>(F.lds, g, S, E); } SEAM(2);
    if (IN(3)) { rope_conv_phase(F); } SEAM(3);
    if (IN(4)) { attn_phase(F); } SEAM(4);
    if (IN(5)) { pg8::Gemm g{WSP(const pg8::bf16_t, WS_AO), WSP(const pg8::bf16_t, WS_WOUT0), MT, DM, DM, 0, DM, 0, 0}; pg8::StaticOrder S; S.init(MT, DM, F.G, (int)blockIdx.x);
        pg8::EpiResH<false> E{F.in[0], F.in[2], WSP(pg8::bf16_t, WS_H), WSP(const float, WS_MOD0) + 2 * DM, 1.0f};
        pg8::gemm_phase<pg8::EpiResH<false>, pg8::StaticOrder, true, true>(F.lds, g, S, E); } SEAM(5);
    if (IN(6)) { norm_phase<FFN8 != 0, true>(F, nullptr, nullptr, F.in[12], WSP(const float, WS_MOD0), 3 * DM, 4 * DM, MT); } SEAM(6);
    const int GWK7 = F.G >= 2 * MK_NCV7 ? F.G - MK_NCV7 : F.G, GWK8 = F.G >= 2 * MK_NCV8 ? F.G - MK_NCV8 : F.G;
    if (IN(7) && (int)blockIdx.x < GWK7) { pg8::Gemm g{XN, WSP(const pg8::bf16_t, WS_WGU0), MT, 2 * DFF, FFN8 ? DM / 2 : DM, 0, FFN8 ? DM / 2 : DM, 0, 0}; pg8::StaticOrder S; S.init(MT, 2 * DFF, GWK7, (int)blockIdx.x);
        if constexpr (FFN8) { pg8::EpiSwiGLU8 E{WSP(unsigned char, WS_HID), DFF, 4.0f, 1.0f / 64.0f}; pg8::gemm_phase<pg8::EpiSwiGLU8, pg8::StaticOrder, true, true, true>(F.lds, g, S, E); }
        else { pg8::EpiSwiGLU E{WSP(pg8::bf16_t, WS_HID), DFF}; pg8::gemm_phase<pg8::EpiSwiGLU, pg8::StaticOrder, true, true>(F.lds, g, S, E); } } SEAM(7);
    if (IN(8) && (int)blockIdx.x < GWK8) { pg8::Gemm g{WSP(const pg8::bf16_t, WS_HID), WSP(const pg8::bf16_t, WS_WD0), MT, DM, FFN8 ? DFF / 2 : DFF, 0, FFN8 ? DFF / 2 : DFF, 0, 0}; pg8::StaticOrder S; S.init(MT, DM, GWK8, (int)blockIdx.x);
        pg8::EpiResH<true> E{nullptr, nullptr, WSP(pg8::bf16_t, WS_H), WSP(const float, WS_MOD0) + 5 * DM, FFN8 ? 1.0f / 256.0f : 1.0f};
        pg8::gemm_phase<pg8::EpiResH<true>, pg8::StaticOrder, true, true, FFN8 != 0>(F.lds, g, S, E); } SEAM(8);
    if (IN(9)) { norm_phase<false, true>(F, nullptr, nullptr, F.in[18], WSP(const float, WS_MOD1), 0, DM, MT); } SEAM(9);
    if (IN(10)) { pg8::Gemm g{XN, WSP(const pg8::bf16_t, WS_WIN1), MT, 2 * DM, DM, 0, DM, 0, 0}; pg8::StaticOrder S; S.init(MT, 2 * DM, F.G, (int)blockIdx.x);
        pg8::EpiBf16 E{WSP(pg8::bf16_t, WS_Z), 2 * DM, 8, 0, 1.0f};
        pg8::gemm_phase<pg8::EpiBf16, pg8::StaticOrder, true, true>(F.lds, g, S, E); } SEAM(10);
    if (IN(11)) { rglru_pass<false>(F); } SEAM(11);
    if (IN(13)) { rglru_pass<true>(F); } SEAM(13);
    if (IN(14)) { pg8::Gemm g{WSP(const pg8::bf16_t, WS_AO), WSP(const pg8::bf16_t, WS_WOUT1), ML, DM, DM, 0, DM, 0, 0}; pg8::StaticOrder S; S.init(ML, DM, F.G, (int)blockIdx.x);
        pg8::EpiResH<true> E{nullptr, nullptr, WSP(pg8::bf16_t, WS_H), WSP(const float, WS_MOD1) + 2 * DM, 1.0f};
        pg8::gemm_phase<pg8::EpiResH<true>, pg8::StaticOrder, true, true>(F.lds, g, S, E); } SEAM(14);
    if (IN(15)) { route_phase(F); } SEAM(15);
    if (IN(17)) { pg8::Gemm g{WSP(const pg8::bf16_t, WS_XGS), WSP(const pg8::bf16_t, WS_MWGU), CAP, 2 * DFFE, DM / 2, (size_t)2 * DFFE * DM, DM / 2, 0x79797979, 0x7F7F7F7F}; pg8::MoeOrder S; S.init((const int*)(F.ctl + CW_CNT), 2 * DFFE, 1, F.G, (int)blockIdx.x); S.atile = ML / 256;
        pg8::EpiSwiGLU8 E{WSP(unsigned char, WS_HID), DFFE, 4.0f, 1.0f / 64.0f};
        pg8::gemm_phase<pg8::EpiSwiGLU8, pg8::MoeOrder, true, false, true>(F.lds, g, S, E); } SEAM(17);
    if (IN(18)) { pg8::Gemm g{WSP(const pg8::bf16_t, WS_HID), WSP(const pg8::bf16_t, WS_MWD), CAP, DM, DFFE / 2, (size_t)DM * DFFE, DFFE / 2, 0x79797979, 0x7D7D7D7D}; pg8::MoeOrder S; S.init((const int*)(F.ctl + CW_CNT), DM, 1, F.G, (int)blockIdx.x, 0, Y2_FULL_TILES);
        pg8::EpiBf16 E{WSP(pg8::bf16_t, WS_Z), DM, 0, 0, 1.0f / (64.0f * 4.0f)};
        pg8::gemm_phase<pg8::EpiBf16, pg8::MoeOrder, true, true, true>(F.lds, g, S, E);
        pg8::Gemm g2{WSP(const pg8::bf16_t, WS_HID), WSP(const pg8::bf16_t, WS_MWD), CAP, DM, DFFE / 2, (size_t)DM * DFFE, DFFE / 14, 0x79797979, 0x7D7D7D7D}; pg8::MoeOrder S2; S2.init((const int*)(F.ctl + CW_CNT), DM, 7, F.G, (int)blockIdx.x, Y2_FULL_TILES);
        pg8::EpiBf16 E2{WSP(pg8::bf16_t, WS_XN) - (size_t)Y2_FULL_TILES * 256 * DM, DM, 0, (size_t)Y2_PART_ROWS * DM, 1.0f / (64.0f * 4.0f)};
        pg8::gemm_phase<pg8::EpiBf16, pg8::MoeOrder, true, true, true>(F.lds, g2, S2, E2); } SEAM(18);
    if (IN(19)) { final_phase(F); }
#undef IN
#undef SEAM
#undef SEAM_A
}

extern "C" void kernel_launch(void* const* d_in, const int* in_sizes, int n_in, void* d_out, int out_size, void* d_ws, size_t ws_size, hipStream_t stream) {
    static int grid = 0;
    if (grid == 0) {
        if (n_in != 35 || out_size != ML * DM || ws_size < WS_END) { fprintf(stderr, "kernel_launch: unexpected shapes (n_in %d out %d ws %zu need %zu)\n", n_in, out_size, ws_size, (size_t)WS_END); grid = -1; return; }
        int dev = 0, cus = 0, per_cu = 0;
        if (hipGetDevice(&dev) != hipSuccess || hipDeviceGetAttribute(&cus, hipDeviceAttributeMultiprocessorCount, dev) != hipSuccess) { grid = -1; return; }
        if (hipFuncSetAttribute((const void*)fwd_kernel, hipFuncAttributeMaxDynamicSharedMemorySize, LDS_BYTES) != hipSuccess) { fprintf(stderr, "kernel_launch: hipFuncSetAttribute failed\n"); grid = -1; return; }
        if (hipOccupancyMaxActiveBlocksPerMultiprocessor(&per_cu, (const void*)fwd_kernel, NWAVES * 64, LDS_BYTES) != hipSuccess || per_cu < 1) { fprintf(stderr, "kernel_launch: occupancy query says %d\n", per_cu); }
        (void)hipGetLastError();
        grid = cus;
    }
    if (grid < 0) return;
    (void)hipMemsetAsync((char*)d_ws + WS_CTL, 0, CTL_ZERO_BYTES, stream);
    Args a{};
    for (int i = 0; i < 35; ++i) a.in[i] = (const float*)d_in[i];
    a.out = (float*)d_out; a.ws = (unsigned char*)d_ws;
#if MK_ONE_LAUNCH
    a.ph_lo = 0; a.ph_hi = N_PHASES;
    hipLaunchKernelGGL(fwd_kernel, dim3(grid), dim3(NWAVES * 64), LDS_BYTES, stream, a);
#else
    for (int p = 0; p < N_PHASES; ++p) { a.ph_lo = p; a.ph_hi = p + 1;
        hipLaunchKernelGGL(fwd_kernel, dim3(grid), dim3(NWAVES * 64), LDS_BYTES, stream, a); }
#endif
}
```
